# Optimizing an MI355X kernel written in HIP

```python
import math
import jax, jax.numpy as jnp
from jax import lax
import numpy as np

D_MODEL = 1024
BATCH = 16
SEQ = 2048
DEPTH = 1
DEC_BATCH = 4
DEC_SEQ = 4096
PAST_LEN = 128

GRID_W = 64
MIX_WIDTH = D_MODEL
ATTN_WIDTH = D_MODEL // 2
HYENA_WIDTH = MIX_WIDTH - ATTN_WIDTH
HEAD_DIM = 64
N_ATTN_HEADS = ATTN_WIDTH // HEAD_DIM
HYENA_GROUP = 64
N_HYENA_GROUPS = HYENA_WIDTH // HYENA_GROUP
NA_ROWS_MAX = 8
NA_COLS = 16
HYENA_ORDER = 2
N_FILTERS = HYENA_ORDER - 1
FILTER_EMB = 33
FILTER_HIDDEN = 64
FILTER_INNER = 2
DECAY_TARGET = 1e-2
FAST_DECAY_PCT = 0.3
SLOW_DECAY_PCT = 1.5
MAX_DECAY = math.log(DECAY_TARGET) / FAST_DECAY_PCT
MIN_DECAY = math.log(DECAY_TARGET) / SLOW_DECAY_PCT
SHORT_CONV = 3
D_FF = 2816
FFN_CONV = 3
ALPHA = (2 * DEPTH) ** 0.25
BETA = (8 * DEPTH) ** -0.25
LN_EPS = 1e-5
RMS_EPS = 1e-6

kernel_name = "hybrid_natten_hyena_encoder"


def _layer_norm(x, g, b):
    x32 = x.astype(jnp.float32)
    mu = jnp.mean(x32, -1, keepdims=True)
    var = jnp.mean(jnp.square(x32 - mu), -1, keepdims=True)
    y = (x32 - mu) * lax.rsqrt(var + LN_EPS)
    return (y * g.astype(jnp.float32) + b.astype(jnp.float32)).astype(x.dtype)


def _rms_norm(x, g):
    x32 = x.astype(jnp.float32)
    y = x32 * lax.rsqrt(jnp.mean(jnp.square(x32), -1, keepdims=True) + RMS_EPS)
    return (y * g.astype(jnp.float32)).astype(x.dtype)


def _dwconv3(u, w, b):
    up = jnp.pad(u, ((0, 0), (1, 1), (0, 0)))
    return up[:, :-2] * w[0] + up[:, 1:-1] * w[1] + up[:, 2:] * w[2] + b


def _neighbourhood_attention(q, k, v, rpb):
    bsz, seq_len, _ = q.shape
    rows = seq_len // GRID_W
    kr = min(NA_ROWS_MAX, rows)
    shp = (bsz, rows, GRID_W, N_ATTN_HEADS, HEAD_DIM)
    q = q.reshape(shp) * (HEAD_DIM ** -0.5)
    k = k.reshape(shp)
    v = v.reshape(shp)
    r = np.arange(rows)
    row_idx = np.clip(r - kr // 2, 0, rows - kr)[:, None] + np.arange(kr)[None, :]
    c = np.arange(GRID_W)
    col_start = np.clip(c - NA_COLS // 2, 0, GRID_W - NA_COLS)
    col_mask = (c[None, :] >= col_start[:, None]) & (c[None, :] < col_start[:, None] + NA_COLS)
    dr = (row_idx - r[:, None]) + (NA_ROWS_MAX - 1)
    dc = np.clip(c[None, :] - c[:, None], -(NA_COLS - 1), NA_COLS - 1) + (NA_COLS - 1)
    bias = rpb[:, dr[:, None, :, None], dc[None, :, None, :]]
    k_blk = jnp.take(k, row_idx, axis=1)
    v_blk = jnp.take(v, row_idx, axis=1)
    s = jnp.einsum("brqhd,brikhd->bhrqik", q, k_blk).astype(jnp.float32)
    s = jnp.where(col_mask[None, None, None, :, None, :], s + bias.astype(jnp.float32)[None], -jnp.inf)
    p = jax.nn.softmax(s.reshape(s.shape[:4] + (kr * GRID_W,)), axis=-1).reshape(s.shape)
    o = jnp.einsum("bhrqik,brikhd->brqhd", p.astype(v.dtype), v_blk)
    return o.reshape(bsz, seq_len, N_ATTN_HEADS * HEAD_DIM)


def _hyena_filter_spectrum(seq_len, w1, b1, freq, w_inner, b_inner, w3):
    f32 = jnp.float32
    w1, b1, freq, w_inner, b_inner, w3 = (a.astype(f32) for a in (w1, b1, freq, w_inner, b_inner, w3))
    t = jnp.linspace(0.0, 1.0, seq_len, dtype=f32)[:, None]
    bands = (FILTER_EMB - 1) // 2
    freqs = jnp.linspace(1e-4, bands - 1, bands, dtype=f32)
    ang = (2.0 * math.pi * jnp.arange(seq_len, dtype=f32) / seq_len)[:, None] * freqs[None, :]
    z = jnp.concatenate([t, jnp.cos(ang), -jnp.sin(ang)], axis=-1)
    h = jnp.sin(freq * (z @ w1 + b1))
    for i in range(FILTER_INNER):
        h = jnp.sin(freq * (h @ w_inner[i] + b_inner[i]))
    h = (h @ w3).reshape(seq_len, 2, N_FILTERS, HYENA_WIDTH)
    deltas = jnp.abs(jnp.linspace(MIN_DECAY, MAX_DECAY, HYENA_WIDTH, dtype=f32))
    decay = jnp.exp(-t * deltas[None, :])
    h = h * decay[:, None, None, :]
    h_fwd, h_bwd = h[:, 0], h[:, 1]
    kern = jnp.concatenate([h_fwd, jnp.zeros_like(h_fwd[:1]), h_bwd[:0:-1]], axis=0)
    return jnp.fft.rfft(kern, axis=0)


def _hyena_mixer(u3, short_w, short_b, w1, b1, freq, w_inner, b_inner, w3, fbias):
    seq_len = u3.shape[1]
    uc = _dwconv3(u3, short_w, short_b)
    gates = [uc[..., o * HYENA_WIDTH:(o + 1) * HYENA_WIDTH].astype(jnp.float32) for o in range(HYENA_ORDER)]
    z = uc[..., HYENA_ORDER * HYENA_WIDTH:].astype(jnp.float32)
    kf = _hyena_filter_spectrum(seq_len, w1, b1, freq, w_inner, b_inner, w3)
    fb = fbias.astype(jnp.float32)
    for o, gate in enumerate(reversed(gates[1:])):
        z = z * gate
        zf = jnp.fft.rfft(z, n=2 * seq_len, axis=1)
        z = jnp.fft.irfft(zf * kf[:, o][None], n=2 * seq_len, axis=1)[:, :seq_len] + z * fb[o]
    return (z * gates[0]).astype(u3.dtype)


def _encoder_layer(x, w_in, short_w, short_b, rpb, filt_w1, filt_b1, filt_freq, filt_w_inner,
                   filt_b_inner, filt_w3, filt_bias, g_attn, g_hyena, w_out, ln1_g, ln1_b,
                   ffn_w_in, ffn_conv_w, ffn_conv_b, ffn_w_out, ln2_g, ln2_b):
    proj = jnp.einsum("bld,de->ble", x, w_in)
    q = proj[..., :ATTN_WIDTH]
    k = proj[..., ATTN_WIDTH:2 * ATTN_WIDTH]
    v = proj[..., 2 * ATTN_WIDTH:3 * ATTN_WIDTH]
    attn = _neighbourhood_attention(q, k, v, rpb)
    hy = _hyena_mixer(proj[..., 3 * ATTN_WIDTH:], short_w, short_b, filt_w1, filt_b1, filt_freq,
                      filt_w_inner, filt_b_inner, filt_w3, filt_bias)
    merged = jnp.concatenate([_rms_norm(attn, g_attn), _rms_norm(hy, g_hyena)], axis=-1)
    x = _layer_norm(ALPHA * x + merged @ w_out, ln1_g, ln1_b)
    u = _dwconv3(x @ ffn_w_in, ffn_conv_w, ffn_conv_b)
    hid = u[..., :D_FF] * jax.nn.gelu(u[..., D_FF:], approximate=False)
    x = _layer_norm(ALPHA * x + hid @ ffn_w_out, ln2_g, ln2_b)
    return x


def _trunk(x, params):
    for layer in range(DEPTH):
        x = _encoder_layer(x, *[p[layer] for p in params])
    return x


def setup_inputs(seed: int = 0) -> dict:
    key = jax.random.key(seed)
    ks = jax.random.split(key, 26)
    f32 = jnp.float32

    def nrm(k, shape, scale):
        return jax.random.normal(k, shape, f32) * scale

    n_proj = 3 * ATTN_WIDTH + (HYENA_ORDER + 1) * HYENA_WIDTH
    n_hy = (HYENA_ORDER + 1) * HYENA_WIDTH
    return {
        "x_prompt": nrm(ks[0], (BATCH, SEQ, D_MODEL), 1.0),
        "x_sample": nrm(ks[1], (DEC_BATCH, DEC_SEQ, D_MODEL), 1.0),
        "w_in": nrm(ks[2], (DEPTH, D_MODEL, n_proj), D_MODEL ** -0.5),
        "short_w": nrm(ks[3], (DEPTH, SHORT_CONV, n_hy), SHORT_CONV ** -0.5),
        "short_b": nrm(ks[4], (DEPTH, n_hy), 0.02),
        "rpb": nrm(ks[5], (DEPTH, N_ATTN_HEADS, 2 * NA_ROWS_MAX - 1, 2 * NA_COLS - 1), 0.1),
        "filt_w1": nrm(ks[6], (DEPTH, FILTER_EMB, FILTER_HIDDEN), FILTER_EMB ** -0.5),
        "filt_b1": nrm(ks[7], (DEPTH, FILTER_HIDDEN), 0.1),
        "filt_freq": 1.0 + nrm(ks[8], (DEPTH, FILTER_HIDDEN), 0.05),
        "filt_w_inner": nrm(ks[9], (DEPTH, FILTER_INNER, FILTER_HIDDEN, FILTER_HIDDEN), FILTER_HIDDEN ** -0.5),
        "filt_b_inner": nrm(ks[10], (DEPTH, FILTER_INNER, FILTER_HIDDEN), 0.1),
        "filt_w3": nrm(ks[11], (DEPTH, FILTER_HIDDEN, 2 * N_FILTERS * HYENA_WIDTH), FILTER_HIDDEN ** -0.5),
        "filt_bias": nrm(ks[12], (DEPTH, N_FILTERS, HYENA_WIDTH), 1.0),
        "g_attn": 1.0 + nrm(ks[13], (DEPTH, ATTN_WIDTH), 0.02),
        "g_hyena": 1.0 + nrm(ks[14], (DEPTH, HYENA_WIDTH), 0.02),
        "w_out": nrm(ks[15], (DEPTH, MIX_WIDTH, D_MODEL), MIX_WIDTH ** -0.5 * BETA),
        "ln1_g": 1.0 + nrm(ks[16], (DEPTH, D_MODEL), 0.02),
        "ln1_b": nrm(ks[17], (DEPTH, D_MODEL), 0.02),
        "ffn_w_in": nrm(ks[18], (DEPTH, D_MODEL, 2 * D_FF), D_MODEL ** -0.5),
        "ffn_conv_w": nrm(ks[19], (DEPTH, FFN_CONV, 2 * D_FF), FFN_CONV ** -0.5),
        "ffn_conv_b": nrm(ks[20], (DEPTH, 2 * D_FF), 0.02),
        "ffn_w_out": nrm(ks[21], (DEPTH, D_FF, D_MODEL), D_FF ** -0.5 * BETA),
        "ln2_g": 1.0 + nrm(ks[22], (DEPTH, D_MODEL), 0.02),
        "ln2_b": nrm(ks[23], (DEPTH, D_MODEL), 0.02),
    }


def reference(x_prompt, x_sample, w_in, short_w, short_b, rpb, filt_w1, filt_b1, filt_freq,
              filt_w_inner, filt_b_inner, filt_w3, filt_bias, g_attn, g_hyena, w_out, ln1_g, ln1_b,
              ffn_w_in, ffn_conv_w, ffn_conv_b, ffn_w_out, ln2_g, ln2_b):
    params = (w_in, short_w, short_b, rpb, filt_w1, filt_b1, filt_freq, filt_w_inner, filt_b_inner,
              filt_w3, filt_bias, g_attn, g_hyena, w_out, ln1_g, ln1_b, ffn_w_in, ffn_conv_w,
              ffn_conv_b, ffn_w_out, ln2_g, ln2_b)
    y_prompt = _trunk(x_prompt, params)
    y_sample = _trunk(x_sample, params)
    return (y_prompt, y_sample)
```

```cpp
#include <hip/hip_runtime.h>
#include <hip/hip_cooperative_groups.h>
#include <cstdio>
#include <cstdint>
namespace cg = cooperative_groups;
namespace pg8 {
#define PG8_LAS __attribute__((address_space(3)))
typedef unsigned short bf16_t;
typedef short bf16x8 __attribute__((ext_vector_type(8)));
typedef float f32x4 __attribute__((ext_vector_type(4)));
typedef unsigned u32x4 __attribute__((ext_vector_type(4)));
constexpr int BM = 256, BK = 64, HALF = 128, HTB = HALF * BK * 2  , STAGE_BYTES = 8 * HTB, NXCD = 8, WGM = 8;

__host__ __device__ __forceinline__ int lds_byte(int r, int c) { const int st = (r >> 4) * 2 + (c >> 5), rr = r & 15, cc = c & 31, ob = rr * 64 + cc * 2; return st * 1024 + (ob ^ (((ob >> 9) & 1) << 5)); }
__host__ __device__ __forceinline__ void stage_rc(int b, int& R, int& C) { const int st = b / 1024, sb = b % 1024, swz = sb ^ (((sb >> 9) & 1) << 5); R = (st >> 1) * 16 + swz / 64; C = (st & 1) * 32 + (swz % 64) / 2; }
__host__ __device__ __forceinline__ int perm32(int rho) { const int n = rho >> 4, i = rho & 15; return 8 * (i >> 2) + 4 * n + (i & 3); }

struct Unit { int pm, pn; };
struct Gemm { const bf16_t* A; const bf16_t* Bt; int M, N, K; };

struct StaticOrder {
    int nM, nN, nwg, G, c;
    __host__ __device__ void init(int M, int N, int G_, int c_) { nM = M / BM; nN = N / BM; nwg = nM * nN; G = G_; c = c_; }
    __host__ __device__ bool next(int i, Unit& u) const {
        const long L = (long)i * G + c; if (L >= nwg) return false;
        int wgid = (int)L; { const int q = nwg / NXCD, r = nwg % NXCD, xcd = wgid % NXCD, off = wgid / NXCD; wgid = (xcd < r ? xcd * (q + 1) : r * (q + 1) + (xcd - r) * q) + off; }
        const int nig = WGM * nN, gid = wgid / nig, fm = gid * WGM, gsz = (nM - fm) < WGM ? (nM - fm) : WGM;
        u.pm = fm + ((wgid % nig) % gsz); u.pn = (wgid % nig) / gsz; return true;
    }
    __device__ __forceinline__ void a_ready(const Unit&) const {}
    __device__ __forceinline__ void done(const Unit&) const {}
};

__device__ __forceinline__ unsigned cvt_pk_bf16(float lo, float hi) { unsigned r; asm volatile("v_cvt_pk_bf16_f32 %0, %1, %2" : "=v"(r) : "v"(lo), "v"(hi)); return r; }
typedef float f32x2 __attribute__((ext_vector_type(2)));
__device__ __forceinline__ f32x2 gelu_pk(f32x2 v) {
    const f32x2 av = __builtin_elementwise_abs(v), d = av * 0.2316418882f + 1.0f;
    f32x2 t; t.x = __builtin_amdgcn_rcpf(d.x); t.y = __builtin_amdgcn_rcpf(d.y);
    f32x2 q = t * 0.5307027145f + (-0.7265760135f); q = q * t + 0.7107068705f; q = q * t + (-0.142248368f); q = q * t + 0.127414796f; q = q * t;
    const f32x2 s = (v * v) * (-0.72134752044f);
    f32x2 e; e.x = __builtin_amdgcn_exp2f(s.x); e.y = __builtin_amdgcn_exp2f(s.y);
    const f32x2 m = v * (q * e), r = v - m;
    f32x2 o; o.x = v.x < 0.f ? m.x : r.x; o.y = v.y < 0.f ? m.y : r.y; return o;
}

template <int ACT  > struct EpiBf16 {
    static constexpr bool PERM = true, AFTER_DRAIN = false; static_assert(ACT == 0 || ACT == 1, "EpiBf16: ACT is 0 (none) or 1 (gelu_pk)");
    bf16_t* O; int ldc; const float* bias; int split_cols; size_t split_stride; float scale0;
    __device__ __forceinline__ void operator()(const f32x4 (&acc)[2][2][4][2], const Unit& u, int wr, int wc, int fr, int fq) const {
        const int row0 = u.pm * BM + wr * 64 + fr; int colt = u.pn * BM; bf16_t* base = O;
        float sc = 1.f; if (split_cols) { const int t = colt / split_cols; base += (size_t)t * split_stride; colt -= t * split_cols; if (t == 0) sc = scale0; }
        const int col0 = colt + wc * 32 + 8 * fq, bcol0 = u.pn * BM + wc * 32 + 8 * fq;
        f32x4 bv[2][2];
#pragma unroll
        for (int bj = 0; bj < 2; ++bj)
#pragma unroll
            for (int n = 0; n < 2; ++n) bv[bj][n] = bias ? *(const f32x4*)(bias + bcol0 + bj * HALF + 4 * n) : (f32x4){0.f, 0.f, 0.f, 0.f};
#pragma unroll
        for (int ai = 0; ai < 2; ++ai)
#pragma unroll
            for (int m = 0; m < 4; ++m) { bf16_t* rowp = base + (size_t)(row0 + ai * HALF + m * 16) * ldc + col0;
#pragma unroll
                for (int bj = 0; bj < 2; ++bj) { f32x4 v0 = acc[ai][bj][m][0] + bv[bj][0], v1 = acc[ai][bj][m][1] + bv[bj][1];
                    if (ACT == 1) { f32x2 a = gelu_pk((f32x2){v0[0], v0[1]}), b = gelu_pk((f32x2){v0[2], v0[3]}), c = gelu_pk((f32x2){v1[0], v1[1]}), d = gelu_pk((f32x2){v1[2], v1[3]});
                        v0 = (f32x4){a.x, a.y, b.x, b.y}; v1 = (f32x4){c.x, c.y, d.x, d.y}; }
                    v0 = v0 * sc; v1 = v1 * sc; u32x4 w; w.x = cvt_pk_bf16(v0[0], v0[1]); w.y = cvt_pk_bf16(v0[2], v0[3]); w.z = cvt_pk_bf16(v1[0], v1[1]); w.w = cvt_pk_bf16(v1[2], v1[3]);
                    *(u32x4*)(rowp + bj * HALF) = w; } }
    }
};
template <class Epi, class Sched, bool ALIGN_EPI = false, bool SP2 = false>
__device__ __forceinline__ void gemm_phase(PG8_LAS unsigned char* lds, const Gemm g, const Sched& S, const Epi& E) {
    const int tid = threadIdx.x, wid = __builtin_amdgcn_readfirstlane(tid >> 6), lane = tid & 63, wr = wid >> 2, wc = wid & 3, fr = lane & 15, fq = lane >> 4;
    const int K = g.K, nt = K / BK;
    unsigned voffA[2], voffB[2];
#pragma unroll
    for (int i = 0; i < 2; ++i) { int R, C; stage_rc(tid * 16 + i * 8192, R, C); const int Rb = Epi::PERM ? ((R & ~31) + perm32(R & 31)) : R;
        voffA[i] = (unsigned)(R * K + C) * 2u; voffB[i] = (unsigned)(Rb * K + C) * 2u; }
    const size_t kstep = (size_t)(BK * 2);
    const size_t hstep = (size_t)HALF * K * 2;
    const size_t tstep = 2 * hstep;
    const unsigned ldsw = (unsigned)wid * 1024u;
    const int aoff = lds_byte(wr * 64 + fr, fq * 8), boff = lds_byte(wc * 32 + fr, fq * 8);
#define PG8_SA(b, h) (((b) * 2 + (h)) * HTB)
#define PG8_SB(b, h) ((4 + (b) * 2 + (h)) * HTB)
#define PG8_STAGE(bufoff, gbase, voff) do { _Pragma("unroll") for (int _i = 0; _i < 2; ++_i) \
        __builtin_amdgcn_global_load_lds((const unsigned*)((const char*)(gbase) + (voff)[_i]), (PG8_LAS unsigned*)(lds + (bufoff) + ldsw + _i * 8192), 16, 0, 0); } while (0)
#define PG8_LDA(dst, b, h) do { _Pragma("unroll") for (int m = 0; m < 4; ++m) _Pragma("unroll") for (int k = 0; k < 2; ++k) dst[m][k] = *(const PG8_LAS bf16x8*)(lds + PG8_SA(b, h) + aoff + m * 2048 + k * 1024); } while (0)
#define PG8_LDB(dst, b, h) do { _Pragma("unroll") for (int n = 0; n < 2; ++n) _Pragma("unroll") for (int k = 0; k < 2; ++k) dst[n][k] = *(const PG8_LAS bf16x8*)(lds + PG8_SB(b, h) + boff + n * 2048 + k * 1024); } while (0)
#define PG8_MMA(ai, bj, At, Bt) do { __builtin_amdgcn_s_setprio(1); _Pragma("unroll") for (int m = 0; m < 4; ++m) _Pragma("unroll") for (int n = 0; n < 2; ++n) _Pragma("unroll") for (int k = 0; k < 2; ++k) \
        acc[ai][bj][m][n] = __builtin_amdgcn_mfma_f32_16x16x32_bf16(Bt[n][k], At[m][k], acc[ai][bj][m][n], 0, 0, 0); __builtin_amdgcn_s_setprio(0); } while (0)
#define PG8_WAIT_V(n) asm volatile("s_waitcnt vmcnt(" #n ")" ::: "memory")
#define PG8_WAIT_L(n) asm volatile("s_waitcnt lgkmcnt(" #n ")" ::: "memory")
#define PG8_BAR __builtin_amdgcn_s_barrier()
#define PG8_SCHED __builtin_amdgcn_sched_barrier(0)
    Unit cur, nxt; int ui = 0;
    if (!S.next(0, cur)) return;
    f32x4 acc[2][2][4][2];
#pragma unroll
    for (int a = 0; a < 2; ++a)
#pragma unroll
        for (int b = 0; b < 2; ++b)
#pragma unroll
            for (int m = 0; m < 4; ++m)
#pragma unroll
                for (int n = 0; n < 2; ++n) acc[a][b][m][n] = (f32x4){0.f, 0.f, 0.f, 0.f};
    bf16x8 At[4][2], B0[2][2], B1[2][2];
    const char* cA = (const char*)g.A + (size_t)cur.pm * tstep; const char* cB = (const char*)g.Bt + (size_t)cur.pn * tstep;
    S.a_ready(cur);
    if constexpr (SP2) {
        PG8_STAGE(PG8_SB(0, 0), cB, voffB); PG8_STAGE(PG8_SB(0, 1), cB + hstep, voffB); PG8_STAGE(PG8_SA(0, 0), cA, voffA); PG8_STAGE(PG8_SA(0, 1), cA + hstep, voffA);
        if (wr == 1) PG8_BAR;
        PG8_WAIT_V(2); PG8_BAR;
        PG8_STAGE(PG8_SB(1, 0), cB + kstep, voffB); PG8_STAGE(PG8_SA(1, 0), cA + kstep, voffA); PG8_STAGE(PG8_SB(1, 1), cB + hstep + kstep, voffB);
        PG8_WAIT_V(6); PG8_BAR;
    } else {
        PG8_STAGE(PG8_SB(0, 0), cB, voffB); PG8_STAGE(PG8_SA(0, 0), cA, voffA); PG8_STAGE(PG8_SB(0, 1), cB + hstep, voffB); PG8_STAGE(PG8_SA(0, 1), cA + hstep, voffA);
        if (wr == 1) PG8_BAR;
        PG8_WAIT_V(4); PG8_BAR;
        PG8_STAGE(PG8_SB(1, 0), cB + kstep, voffB); PG8_STAGE(PG8_SA(1, 0), cA + kstep, voffA); PG8_STAGE(PG8_SB(1, 1), cB + hstep + kstep, voffB);
        PG8_WAIT_V(6); PG8_BAR;
    }
    for (;;) {
        const bool has_next = S.next(ui + 1, nxt);
        const char* nA = has_next ? (const char*)g.A + (size_t)nxt.pm * tstep : cA; const char* nB = has_next ? (const char*)g.Bt + (size_t)nxt.pn * tstep : cB;
        for (int t = 0; t < nt; t += 2) {
            const bool last = (t == nt - 2);
            const char* a1 = cA + (size_t)(t + 1) * kstep;
            const char* a2 = last ? nA : cA + (size_t)(t + 2) * kstep; const char* b2 = last ? nB : cB + (size_t)(t + 2) * kstep;
            const char* a3 = a2 + kstep; const char* b3 = b2 + kstep;
            if (last && has_next) S.a_ready(nxt);
            if constexpr (SP2) {
            PG8_LDB(B0, 0, 0); PG8_LDB(B1, 0, 1); PG8_SCHED; PG8_LDA(At, 0, 0); PG8_STAGE(PG8_SA(1, 1), a1 + hstep, voffA);
            PG8_WAIT_V(8); PG8_WAIT_L(0); PG8_BAR; PG8_MMA(0, 0, At, B0); PG8_MMA(0, 1, At, B1); PG8_BAR; PG8_SCHED;
            PG8_LDA(At, 0, 1); PG8_STAGE(PG8_SB(0, 0), b2, voffB); PG8_STAGE(PG8_SB(0, 1), b2 + hstep, voffB); PG8_STAGE(PG8_SA(0, 0), a2, voffA);
            PG8_WAIT_V(8); PG8_WAIT_L(0); PG8_BAR; PG8_MMA(1, 0, At, B0); PG8_MMA(1, 1, At, B1); PG8_BAR; PG8_SCHED;
            PG8_LDB(B0, 1, 0); PG8_LDB(B1, 1, 1); PG8_SCHED; PG8_LDA(At, 1, 0); PG8_STAGE(PG8_SA(0, 1), a2 + hstep, voffA);
            PG8_WAIT_V(8); PG8_WAIT_L(0); PG8_BAR; PG8_MMA(0, 0, At, B0); PG8_MMA(0, 1, At, B1); PG8_BAR; PG8_SCHED;
            PG8_LDA(At, 1, 1); PG8_STAGE(PG8_SB(1, 0), b3, voffB); PG8_STAGE(PG8_SB(1, 1), b3 + hstep, voffB); PG8_STAGE(PG8_SA(1, 0), a3, voffA);
            PG8_WAIT_V(8); PG8_WAIT_L(0); PG8_BAR; PG8_MMA(1, 0, At, B0); PG8_MMA(1, 1, At, B1); PG8_BAR; PG8_SCHED;
            } else {
            PG8_LDB(B0, 0, 0); PG8_SCHED; PG8_LDA(At, 0, 0); PG8_STAGE(PG8_SA(1, 1), a1 + hstep, voffA);
            PG8_WAIT_L(8); PG8_BAR; PG8_WAIT_L(0); PG8_MMA(0, 0, At, B0); PG8_BAR; PG8_SCHED;
            PG8_LDB(B1, 0, 1); PG8_STAGE(PG8_SB(0, 0), b2, voffB);
            PG8_BAR; PG8_WAIT_L(0); PG8_MMA(0, 1, At, B1); PG8_BAR;
            PG8_LDA(At, 0, 1); PG8_STAGE(PG8_SA(0, 0), a2, voffA);
            PG8_BAR; PG8_WAIT_L(0); PG8_MMA(1, 0, At, B0); PG8_BAR; PG8_SCHED;
            PG8_STAGE(PG8_SB(0, 1), b2 + hstep, voffB);
            PG8_WAIT_V(6); PG8_BAR; PG8_MMA(1, 1, At, B1); PG8_BAR;
            PG8_LDB(B0, 1, 0); PG8_SCHED; PG8_LDA(At, 1, 0); PG8_STAGE(PG8_SA(0, 1), a2 + hstep, voffA);
            PG8_WAIT_L(8); PG8_BAR; PG8_WAIT_L(0); PG8_MMA(0, 0, At, B0); PG8_BAR; PG8_SCHED;
            PG8_LDB(B1, 1, 1); PG8_STAGE(PG8_SB(1, 0), b3, voffB);
            PG8_BAR; PG8_WAIT_L(0); PG8_MMA(0, 1, At, B1); PG8_BAR;
            PG8_LDA(At, 1, 1); PG8_STAGE(PG8_SA(1, 0), a3, voffA);
            PG8_BAR; PG8_WAIT_L(0); PG8_MMA(1, 0, At, B0); PG8_BAR; PG8_SCHED;
            PG8_STAGE(PG8_SB(1, 1), b3 + hstep, voffB);
            PG8_WAIT_V(6); PG8_BAR; PG8_MMA(1, 1, At, B1); PG8_BAR;
            }
        }
        if constexpr (ALIGN_EPI) { if (wr == 0) PG8_BAR; }
        if constexpr (!Epi::AFTER_DRAIN) { E(acc, cur, wr, wc, fr, fq); S.done(cur); }
        if (!has_next) break;
#pragma unroll
        for (int a = 0; a < 2; ++a)
#pragma unroll
            for (int b = 0; b < 2; ++b)
#pragma unroll
                for (int m = 0; m < 4; ++m)
#pragma unroll
                    for (int n = 0; n < 2; ++n) acc[a][b][m][n] = (f32x4){0.f, 0.f, 0.f, 0.f};
        cur = nxt; cA = nA; cB = nB; ++ui;
        if constexpr (ALIGN_EPI) { if (wr == 1) PG8_BAR; }
    }
    PG8_WAIT_V(0);
    if constexpr (!ALIGN_EPI) { if (wr == 0) PG8_BAR; }
    PG8_BAR;
    if constexpr (Epi::AFTER_DRAIN) { E.fused(acc, cur, wr, wc, fr, fq, lds, wid, lane); S.done(cur); }
#undef PG8_SA
#undef PG8_SB
#undef PG8_STAGE
#undef PG8_LDA
#undef PG8_LDB
#undef PG8_MMA
#undef PG8_WAIT_V
#undef PG8_WAIT_L
#undef PG8_BAR
#undef PG8_SCHED
}
}
namespace pg8 {
struct EpiAxpyF32 {
    static constexpr bool PERM = false, AFTER_DRAIN = false;
    const float* base; float* out; int ldc; float alpha;
    __device__ __forceinline__ void operator()(const f32x4 (&acc)[2][2][4][2], const Unit& u, int wr, int wc, int fr, int fq) const {
        const int row0 = u.pm * BM + wr * 64 + fr, col0 = u.pn * BM + wc * 32 + 4 * fq;
#pragma unroll
        for (int ai = 0; ai < 2; ++ai)
#pragma unroll
            for (int m = 0; m < 4; ++m) { const size_t ro = (size_t)(row0 + ai * HALF + m * 16) * ldc + col0;
#pragma unroll
                for (int bj = 0; bj < 2; ++bj)
#pragma unroll
                    for (int n = 0; n < 2; ++n) { const size_t off = ro + bj * HALF + n * 16; const f32x4 b = *(const f32x4*)(base + off); *(f32x4*)(out + off) = b * alpha + acc[ai][bj][m][n]; } }
    }
};
}

#define LAS __attribute__((address_space(3)))
typedef unsigned short bf16_t;
typedef short bf16x8 __attribute__((ext_vector_type(8)));
typedef short s16x4 __attribute__((ext_vector_type(4)));
typedef float f32x2 __attribute__((ext_vector_type(2)));
typedef float f32x4 __attribute__((ext_vector_type(4)));
typedef float f32x16 __attribute__((ext_vector_type(16)));
typedef unsigned u32x2 __attribute__((ext_vector_type(2)));
typedef unsigned u32x4 __attribute__((ext_vector_type(4)));
typedef __bf16 bf16x2v __attribute__((ext_vector_type(2)));

constexpr int T_TOK = 49152, DM = 1024, NPROJ = 3072, DFF = 2816, NFF = 5632, HYW = 512;
constexpr int L_P = 2048, L_S = 4096, TOK_P = 32768;
constexpr int CHUNK = 16384, NCHUNK = 3;
constexpr float ALPHA_F = 1.189207115002721f;
constexpr float LN_EPS_F = 1e-5f, RMS_EPS_F = 1e-6f;
constexpr size_t MiB = 1u << 20;
constexpr size_t WS_WIN = 2 * MiB, WS_WOUT = 8 * MiB, WS_WF1 = 10 * MiB, WS_WF2 = 22 * MiB;
constexpr size_t WS_FILT_P = 28 * MiB, WS_FILT_S = 36 * MiB;
constexpr size_t WS_XB = 52 * MiB;
constexpr size_t WS_PROJ = 148 * MiB;
constexpr size_t WS_X1B = 148 * MiB, WS_U = 244 * MiB, WS_HID = 420 * MiB;
constexpr size_t WS_NEED = 508 * MiB;
constexpr int LDS_BYTES = 147456;

__device__ __forceinline__ unsigned pk2(float a, float b) { f32x2 v = {a, b}; bf16x2v r = __builtin_convertvector(v, bf16x2v); return __builtin_bit_cast(unsigned, r); }
__device__ __forceinline__ float bf2f(unsigned short h) { return __builtin_bit_cast(float, (unsigned)h << 16); }
__device__ __forceinline__ float bflo(unsigned w) { return __builtin_bit_cast(float, w << 16); }
__device__ __forceinline__ float bfhi(unsigned w) { return __builtin_bit_cast(float, w & 0xffff0000u); }
#define MFMA32(a, b, c) __builtin_amdgcn_mfma_f32_32x32x16_bf16((a), (b), (c), 0, 0, 0)
#define LDS_WAIT() asm volatile("s_waitcnt lgkmcnt(0)" ::: "memory")
__device__ __forceinline__ int crow(int reg, int h) { return (reg & 3) + 8 * (reg >> 2) + 4 * h; }
__device__ __forceinline__ float sin_turns(float tr) { tr = tr - floorf(tr); return __builtin_amdgcn_sinf(tr); }
__device__ __forceinline__ float fast_sin(float x) { return sin_turns(x * 0.15915494309189535f); }
__device__ __forceinline__ float wave_sum(float v) {
#pragma unroll
    for (int o = 1; o < 64; o <<= 1) v += __shfl_xor(v, o);
    return v;
}

struct Args { const float* in[24]; float* out; unsigned char* ws; int ph_lo, ph_hi; };
enum { I_XP = 0, I_XS, I_WIN, I_SW, I_SB, I_RPB, I_FW1, I_FB1, I_FFREQ, I_FWI, I_FBI, I_FW3, I_FBIAS, I_GA, I_GH, I_WOUT, I_LN1G, I_LN1B, I_FFW1, I_FFCW, I_FFCB, I_FFW2, I_LN2G, I_LN2B };

__device__ __forceinline__ void p0_transpose_item(const float* W, int K, int N, bf16_t* WT, LAS float* scr, int item, int lane) {
    const int nblk = N / 32, kb = item / nblk, nb = item % nblk, k0 = 64 * kb, n0 = 32 * nb;
#pragma unroll 8
    for (int i = 0; i < 32; ++i) { const int kk = 2 * i + (lane >> 5); scr[kk * 33 + (lane & 31)] = W[(size_t)(k0 + kk) * N + n0 + (lane & 31)]; }
    LDS_WAIT();
    const int c = lane & 7;
#pragma unroll
    for (int j = 0; j < 4; ++j) { const int n = (lane >> 3) + 8 * j; const LAS float* s = scr + (8 * c) * 33 + n;
        u32x4 o; o.x = pk2(s[0 * 33], s[1 * 33]); o.y = pk2(s[2 * 33], s[3 * 33]); o.z = pk2(s[4 * 33], s[5 * 33]); o.w = pk2(s[6 * 33], s[7 * 33]);
        *(u32x4*)(WT + (size_t)(n0 + n) * K + k0 + 8 * c) = o; }
    LDS_WAIT();
}

template <int L>
__device__ __forceinline__ void filter_unit(const Args& A, bf16_t* Rg, LAS unsigned char* lds, int chunk, int tid) {
    LAS float* Z = (LAS float*)lds;
    LAS float* H1 = Z + 32 * 36;
    LAS float* H2 = H1 + 32 * 65;
    const float* w1 = A.in[I_FW1]; const float* b1 = A.in[I_FB1]; const float* fq = A.in[I_FFREQ];
    const float* wi = A.in[I_FWI]; const float* bi = A.in[I_FBI]; const float* w3 = A.in[I_FW3];
    const int t0 = chunk * 32;
    for (int idx = tid; idx < 32 * 33; idx += 512) {
        const int p = idx / 33, f = idx % 33, t = t0 + p; float val;
        if (f == 0) val = (float)t / (float)(L - 1);
        else { const int k = (f - 1) & 15; const float fr = 1e-4f + (float)k * ((15.0f - 1e-4f) / 15.0f); const float tr = ((float)t / (float)L) * fr; val = (f <= 16) ? sin_turns(tr + 0.25f) : -sin_turns(tr); }
        Z[p * 36 + f] = val;
    }
    __syncthreads();
#pragma unroll 1
    for (int o = tid; o < 2048; o += 512) { const int p = o >> 6, j = o & 63; float a = b1[j];
#pragma unroll 3
        for (int f = 0; f < 33; ++f) a += Z[p * 36 + f] * w1[f * 64 + j];
        H1[p * 65 + j] = fast_sin(fq[j] * a); }
    __syncthreads();
#pragma unroll 1
    for (int o = tid; o < 2048; o += 512) { const int p = o >> 6, j = o & 63; float a = bi[j];
#pragma unroll 8
        for (int f = 0; f < 64; ++f) a += H1[p * 65 + f] * wi[f * 64 + j];
        H2[p * 65 + j] = fast_sin(fq[j] * a); }
    __syncthreads();
#pragma unroll 1
    for (int o = tid; o < 2048; o += 512) { const int p = o >> 6, j = o & 63; float a = bi[64 + j];
#pragma unroll 8
        for (int f = 0; f < 64; ++f) a += H2[p * 65 + f] * wi[4096 + f * 64 + j];
        H1[p * 65 + j] = fast_sin(fq[j] * a); }
    __syncthreads();
    const int c = tid;
    float af[32], ab[32];
#pragma unroll
    for (int p = 0; p < 32; ++p) { af[p] = 0.f; ab[p] = 0.f; }
#pragma unroll 1
    for (int k = 0; k < 64; ++k) { const float wf = w3[k * 1024 + c], wb = w3[k * 1024 + 512 + c];
#pragma unroll
        for (int p = 0; p < 32; ++p) { const float h = H1[p * 65 + k]; af[p] += h * wf; ab[p] += h * wb; } }
    const float MIN_DECAY = -3.0701134573253945f, MAX_DECAY = -15.350567286626973f;
    const float delta = fabsf(MIN_DECAY + (float)c * ((MAX_DECAY - MIN_DECAY) / 511.0f));
    bf16_t* c0 = Rg + (size_t)c * (4 * L); bf16_t* c1 = c0 + 2 * L;
#pragma unroll
    for (int p = 0; p < 32; ++p) { const int t = t0 + p; const float tl = (float)t / (float)(L - 1); const float dec = __expf(-tl * delta);
        const bf16_t hf = (bf16_t)(pk2(af[p] * dec, 0.f) & 0xffffu), hb = (bf16_t)(pk2(ab[p] * dec, 0.f) & 0xffffu);
        c0[L - t] = hf; c1[L - t - 1] = hf;
        if (t >= 1) { c0[L + t] = hb; c1[L + t - 1] = hb; } else { c0[0] = 0; c1[2 * L - 1] = 0; } }
    __syncthreads();
}

__device__ __forceinline__ void p0_prologue(const Args& A, LAS unsigned char* lds, int tid, int wave, int lane) {
    unsigned char* ws = A.ws;
    const int bx = blockIdx.x, G = gridDim.x;
    for (int u = bx; u < 192; u += G) { if (u < 64) filter_unit<L_P>(A, (bf16_t*)(ws + WS_FILT_P), lds, u, tid); else filter_unit<L_S>(A, (bf16_t*)(ws + WS_FILT_S), lds, u - 64, tid); }
    __syncthreads();
    LAS float* scr = (LAS float*)(lds + wave * 16384);
    const int gw = bx * 8 + wave, NGW = G * 8;
    constexpr int I1 = 16 * 96, I2 = 16 * 32, I3 = 16 * 176, I4 = 44 * 32;
    for (int it = gw; it < I1 + I2 + I3 + I4; it += NGW) {
        int r = it;
        if (r < I1) { p0_transpose_item(A.in[I_WIN], 1024, 3072, (bf16_t*)(ws + WS_WIN), scr, r, lane); continue; } r -= I1;
        if (r < I2) { p0_transpose_item(A.in[I_WOUT], 1024, 1024, (bf16_t*)(ws + WS_WOUT), scr, r, lane); continue; } r -= I2;
        if (r < I3) { p0_transpose_item(A.in[I_FFW1], 1024, 5632, (bf16_t*)(ws + WS_WF1), scr, r, lane); continue; } r -= I3;
        p0_transpose_item(A.in[I_FFW2], 2816, 1024, (bf16_t*)(ws + WS_WF2), scr, r, lane);
    }
    bf16_t* xb = (bf16_t*)(ws + WS_XB);
    for (int m = gw; m < T_TOK; m += NGW) {
        const float* xr = (m < TOK_P) ? (A.in[I_XP] + (size_t)m * DM) : (A.in[I_XS] + (size_t)(m - TOK_P) * DM);
        const f32x4* x4 = (const f32x4*)xr + lane; u32x2* o = (u32x2*)(xb + (size_t)m * DM) + lane;
#pragma unroll
        for (int j = 0; j < 4; ++j) { const f32x4 v = x4[64 * j]; u32x2 w; w.x = pk2(v.x, v.y); w.y = pk2(v.z, v.w); o[64 * j] = w; }
    }
}

__device__ __forceinline__ s16x4 tr_read(unsigned lds_addr) { s16x4 r; asm volatile("ds_read_b64_tr_b16 %0, %1\n\ts_waitcnt lgkmcnt(0)" : "=&v"(r) : "v"(lds_addr) : "memory"); return r; }

__device__ __forceinline__ void attn_pass(const bf16_t* proj, const LAS float* bl, LAS unsigned char* vl, int tok0, int seqbase, int r, int r0, int h, int qt, int lane, unsigned (&ob)[16], float& ssout) {
    const int rr = lane & 31, hh = lane >> 5;
    bf16x8 qf[4];
#pragma unroll
    for (int ks = 0; ks < 4; ++ks) qf[ks] = *(const bf16x8*)(proj + (size_t)(tok0 + 32 * qt + rr) * NPROJ + 64 * h + 16 * ks + 8 * hh);
    f32x16 o[2];
#pragma unroll
    for (int a = 0; a < 2; ++a)
#pragma unroll
        for (int i = 0; i < 16; ++i) o[a][i] = 0.f;
    float m_run = -1e30f, l_run = 0.f;
    const float LOG2E = 1.4426950408889634f;
    const unsigned vbase = (unsigned)(size_t)vl;
    const int i16 = lane & 15, tq = i16 >> 2, tp = i16 & 3, blk = (lane >> 4) & 1;
    const int qc = 32 * qt + rr, cs = min(max(qc - 8, 0), 48);
#pragma unroll 1
    for (int kr = 0; kr < 8; ++kr) {
        const int ktok0 = seqbase + 64 * (r0 + kr);
#pragma unroll
        for (int i = 0; i < 8; ++i) { const int key = (lane >> 3) + 8 * i; const u32x4 v = *(const u32x4*)(proj + (size_t)(ktok0 + key) * NPROJ + 1024 + 64 * h + 8 * (lane & 7));
            *(LAS u32x4*)(vl + key * 144 + 16 * (lane & 7)) = v; }
        f32x16 s[2];
#pragma unroll
        for (int a = 0; a < 2; ++a)
#pragma unroll
            for (int i = 0; i < 16; ++i) s[a][i] = 0.f;
#pragma unroll
        for (int kt = 0; kt < 2; ++kt)
#pragma unroll
            for (int ks = 0; ks < 4; ++ks) { const bf16x8 kf = *(const bf16x8*)(proj + (size_t)(ktok0 + 32 * kt + rr) * NPROJ + 512 + 64 * h + 16 * ks + 8 * hh);
                s[kt] = MFMA32(kf, qf[ks], s[kt]); }
        const int dr = r0 + kr - r + 7; const LAS float* brow = bl + dr * 31 + 15;
        float mx = -1e30f;
#pragma unroll
        for (int kt = 0; kt < 2; ++kt)
#pragma unroll
            for (int i = 0; i < 16; ++i) { const int kc = 32 * kt + crow(i, hh); const bool valid = (kc >= cs) && (kc < cs + 16);
                const int bi = min(max(kc - qc, -15), 15);
                const float v = valid ? (s[kt][i] * 0.125f + brow[bi]) * LOG2E : -INFINITY; s[kt][i] = v; mx = fmaxf(mx, v); }
        mx = fmaxf(mx, __shfl_xor(mx, 32));
        const float mnew = fmaxf(m_run, mx), alpha = __builtin_amdgcn_exp2f(m_run - mnew);
        float sum = 0.f;
#pragma unroll
        for (int kt = 0; kt < 2; ++kt)
#pragma unroll
            for (int i = 0; i < 16; ++i) { const float p = __builtin_amdgcn_exp2f(s[kt][i] - mnew); s[kt][i] = p; sum += p; }
        sum += __shfl_xor(sum, 32);
        l_run = l_run * alpha + sum; m_run = mnew;
#pragma unroll
        for (int dt = 0; dt < 2; ++dt)
#pragma unroll
            for (int i = 0; i < 16; ++i) o[dt][i] *= alpha;
        LDS_WAIT();
#pragma unroll
        for (int kt = 0; kt < 2; ++kt)
#pragma unroll
            for (int st = 0; st < 2; ++st) {
                u32x4 w;
                w.x = pk2(s[kt][8 * st + 0], s[kt][8 * st + 1]); w.y = pk2(s[kt][8 * st + 2], s[kt][8 * st + 3]);
                w.z = pk2(s[kt][8 * st + 4], s[kt][8 * st + 5]); w.w = pk2(s[kt][8 * st + 6], s[kt][8 * st + 7]);
                const bf16x8 pf = __builtin_bit_cast(bf16x8, w);
#pragma unroll
                for (int dt = 0; dt < 2; ++dt) {
                    const unsigned a0 = vbase + (unsigned)((32 * kt + 16 * st + 4 * hh + tq) * 144 + 64 * dt + 32 * blk + 8 * tp);
                    const s16x4 lo = tr_read(a0), hi = tr_read(a0 + 8 * 144);
                    const bf16x8 vf = __builtin_shufflevector(lo, hi, 0, 1, 2, 3, 4, 5, 6, 7);
                    o[dt] = MFMA32(vf, pf, o[dt]);
                }
            }
    }
    const float inv = 1.0f / l_run; float ss = 0.f;
#pragma unroll
    for (int dt = 0; dt < 2; ++dt)
#pragma unroll
        for (int g = 0; g < 4; ++g) { const float v0 = o[dt][4 * g] * inv, v1 = o[dt][4 * g + 1] * inv, v2 = o[dt][4 * g + 2] * inv, v3 = o[dt][4 * g + 3] * inv;
            ss += (v0 * v0 + v1 * v1) + (v2 * v2 + v3 * v3); ob[dt * 8 + 2 * g] = pk2(v0, v1); ob[dt * 8 + 2 * g + 1] = pk2(v2, v3); }
    ss += __shfl_xor(ss, 32);
    ssout = ss;
}

__device__ __forceinline__ void attn_unit(const bf16_t* proj, const float* rpb, const float* g_attn, bf16_t* merged, LAS unsigned char* lds, int u, int wave, int lane) {
    const int tok0 = 64 * u; int rows, r, seqbase;
    if (u < 512) { rows = 32; r = u & 31; seqbase = (u >> 5) * 2048; } else { const int v = u - 512; rows = 64; r = v & 63; seqbase = TOK_P + (v >> 6) * 4096; }
    const int r0 = min(max(r - 4, 0), rows - 8);
    const int h = wave, rr = lane & 31, hh = lane >> 5;
    LAS unsigned char* vl = lds + wave * 9216;
    LAS float* bl = (LAS float*)(lds + 73728 + wave * 1920);
    LAS float* ssq = (LAS float*)(lds + 73728 + 8 * 1920);
    for (int i = lane; i < 465; i += 64) bl[i] = rpb[h * 465 + i];
    LDS_WAIT();
    unsigned ob0[16], ob1[16]; float ss0, ss1;
    attn_pass(proj, bl, vl, tok0, seqbase, r, r0, h, 0, lane, ob0, ss0);
    attn_pass(proj, bl, vl, tok0, seqbase, r, r0, h, 1, lane, ob1, ss1);
    if (hh == 0) { ssq[wave * 64 + rr] = ss0; ssq[wave * 64 + 32 + rr] = ss1; }
    __syncthreads();
#pragma unroll
    for (int qt = 0; qt < 2; ++qt) { float tot = 0.f;
#pragma unroll
        for (int w = 0; w < 8; ++w) tot += ssq[w * 64 + 32 * qt + rr];
        const float rs = 1.0f / sqrtf(tot * (1.0f / 512.0f) + RMS_EPS_F);
#pragma unroll
        for (int dt = 0; dt < 2; ++dt)
#pragma unroll
            for (int g = 0; g < 4; ++g) { const int d = 32 * dt + 8 * g + 4 * hh; const f32x4 gv = *(const f32x4*)(g_attn + 64 * h + d);
                const unsigned p0 = qt ? ob1[dt * 8 + 2 * g] : ob0[dt * 8 + 2 * g], p1 = qt ? ob1[dt * 8 + 2 * g + 1] : ob0[dt * 8 + 2 * g + 1];
                u32x2 w; w.x = pk2(bflo(p0) * rs * gv.x, bfhi(p0) * rs * gv.y); w.y = pk2(bflo(p1) * rs * gv.z, bfhi(p1) * rs * gv.w);
                *(LAS u32x2*)(vl + (32 * qt + rr) * 144 + 2 * d) = w; } }
    LDS_WAIT();
#pragma unroll
    for (int i = 0; i < 8; ++i) { const int q = (lane >> 3) + 8 * i; const u32x4 v = *(const LAS u32x4*)(vl + q * 144 + 16 * (lane & 7));
        *(u32x4*)(merged + (size_t)(tok0 + q) * DM + 64 * h + 8 * (lane & 7)) = v; }
    __syncthreads();
}

__device__ __forceinline__ void hyprep_unit(const bf16_t* proj, const float* sw, const float* sb, bf16_t* vT, bf16_t* x0T, LAS unsigned char* lds, int u, int tid) {
    const int tok0 = 64 * u; int L, s_tile, seqbase;
    if (u < 512) { L = 2048; s_tile = (u & 31) * 64; seqbase = (u >> 5) * 2048; } else { const int v = u - 512; L = 4096; s_tile = (v & 63) * 64; seqbase = TOK_P + (v >> 6) * 4096; }
    LAS unsigned* VL = (LAS unsigned*)lds;
    LAS unsigned* XL = VL + 512 * 33;
    const int half = tid >> 8, cp = tid & 255, c = 2 * cp;
    float w[3][3][2], bb[3][2];
#pragma unroll
    for (int st = 0; st < 3; ++st) {
#pragma unroll
        for (int k = 0; k < 3; ++k) { const f32x2 t = *(const f32x2*)(sw + k * 1536 + st * 512 + c); w[st][k][0] = t.x; w[st][k][1] = t.y; }
        const f32x2 t = *(const f32x2*)(sb + st * 512 + c); bb[st][0] = t.x; bb[st][1] = t.y; }
    const int sbeg = s_tile + 32 * half;
    const bf16_t* pbase = proj + (size_t)(tok0 + 32 * half) * NPROJ + 1536 + c;
    float prev[3][2], cur[3][2], nxt[3][2];
#pragma unroll
    for (int st = 0; st < 3; ++st) {
        unsigned a = 0u; if (sbeg - 1 >= 0) a = *(const unsigned*)(pbase - NPROJ + st * 512);
        const unsigned b = *(const unsigned*)(pbase + st * 512);
        prev[st][0] = bflo(a); prev[st][1] = bfhi(a); cur[st][0] = bflo(b); cur[st][1] = bfhi(b); }
    float vprev[2] = {0.f, 0.f}, xprev[2] = {0.f, 0.f};
#pragma unroll 4
    for (int i = 0; i < 32; ++i) {
        float uc[3][2];
#pragma unroll
        for (int st = 0; st < 3; ++st) {
            unsigned a = 0u; if (sbeg + i + 1 < L) a = *(const unsigned*)(pbase + (size_t)(i + 1) * NPROJ + st * 512);
            nxt[st][0] = bflo(a); nxt[st][1] = bfhi(a);
#pragma unroll
            for (int e = 0; e < 2; ++e) { uc[st][e] = w[st][0][e] * prev[st][e] + w[st][1][e] * cur[st][e] + w[st][2][e] * nxt[st][e] + bb[st][e]; prev[st][e] = cur[st][e]; cur[st][e] = nxt[st][e]; }
        }
        const float v0 = uc[2][0] * uc[1][0], v1 = uc[2][1] * uc[1][1];
        if (i & 1) { const int tp = (32 * half + i) >> 1;
            VL[c * 33 + tp] = pk2(vprev[0], v0); VL[(c + 1) * 33 + tp] = pk2(vprev[1], v1);
            XL[c * 33 + tp] = pk2(xprev[0], uc[0][0]); XL[(c + 1) * 33 + tp] = pk2(xprev[1], uc[0][1]); }
        vprev[0] = v0; vprev[1] = v1; xprev[0] = uc[0][0]; xprev[1] = uc[0][1];
    }
    __syncthreads();
    const size_t obase = (size_t)512 * seqbase + s_tile;
    for (int it = tid; it < 2 * 512 * 8; it += 512) { const int arr = it >> 12, row = (it >> 3) & 511, ch = it & 7;
        const LAS unsigned* src = (arr ? XL : VL) + row * 33 + 4 * ch; u32x4 v; v.x = src[0]; v.y = src[1]; v.z = src[2]; v.w = src[3];
        *(u32x4*)((arr ? x0T : vT) + obase + (size_t)row * L + 8 * ch) = v; }
    __syncthreads();
}

template <int L, int B>
__device__ __forceinline__ void toeplitz_unit(const bf16_t* Rg, bf16_t* vT  , const bf16_t* x0T, const float* fbias, LAS unsigned char* lds, int c, size_t kind_base, int tid, int wave, int lane) {
    constexpr int NB = L / 64, T1PT = 32 / B, PAD = T1PT - 1, NTILES = NB / T1PT, NTW = NTILES / 8;
    constexpr int VROWS = (NB + 2 * PAD) * B, VBYTES = VROWS * 144;
    LAS unsigned char* Vl = lds;
    LAS unsigned* E = (LAS unsigned*)(lds + VBYTES);
    LAS unsigned* O = E + L + 16;
    bf16_t* vch = vT + kind_base + (size_t)c * L;
    const bf16_t* xch = x0T + kind_base + (size_t)c * L;
    for (int idx = tid; idx < NB * B * 8; idx += 512) { const int ch = idx & 7, row = idx >> 3, b = row % B, s1 = row / B;
        const u32x4 v = *(const u32x4*)(vch + (size_t)b * 512 * L + 64 * s1 + 8 * ch);
        *(LAS u32x4*)(Vl + ((s1 + PAD) * B + b) * 144 + 16 * ch) = v; }
    for (int idx = tid; idx < 2 * PAD * B * 9; idx += 512) { const int ch = idx % 9, row = idx / 9; const int rrow = row < PAD * B ? row : (NB * B + row);
        *(LAS u32x4*)(Vl + rrow * 144 + 16 * ch) = (u32x4){0u, 0u, 0u, 0u}; }
    { const u32x4* src = (const u32x4*)(Rg + (size_t)c * 4 * L);
      for (int idx = tid; idx < L / 2; idx += 512) { const int cp = idx / (L / 4), k = idx % (L / 4); const u32x4 v = src[idx]; *(LAS u32x4*)((cp ? O : E) + 4 * k) = v; } }
    __syncthreads();
    const int rr = lane & 31, hh = lane >> 5;
    const LAS unsigned* fb = ((rr & 1) ? O : E) + ((L + 8 * hh - rr - (rr & 1)) >> 1);
    f32x16 acc[NTW][2];
#pragma unroll
    for (int i = 0; i < NTW; ++i)
#pragma unroll
        for (int m = 0; m < 2; ++m)
#pragma unroll
            for (int k = 0; k < 16; ++k) acc[i][m][k] = 0.f;
    const int t1l = rr / B, bcol = rr % B;
    const int dlo = T1PT * wave - (NB - 1), dhi = T1PT * (wave + 8 * (NTW - 1)) + T1PT - 1;
    for (int d = dlo; d <= dhi; ++d) {
        bf16x8 F[6];
#pragma unroll
        for (int q = 0; q < 6; ++q) { const LAS unsigned* p = fb - 8 * (4 * d - 3 + q); u32x4 w; w.x = p[0]; w.y = p[1]; w.z = p[2]; w.w = p[3]; F[q] = __builtin_bit_cast(bf16x8, w); }
#pragma unroll
        for (int i = 0; i < NTW; ++i) { const int j = wave + 8 * i;
            if (d >= T1PT * j - (NB - 1) && d <= T1PT * j + T1PT - 1) {
                const LAS unsigned char* vb = Vl + ((T1PT * j + t1l - d + PAD) * B + bcol) * 144 + 16 * hh;
#pragma unroll
                for (int kt = 0; kt < 4; ++kt) { const bf16x8 bf = *(const LAS bf16x8*)(vb + 32 * kt);
#pragma unroll
                    for (int mt = 0; mt < 2; ++mt) acc[i][mt] = MFMA32(F[2 * mt - kt + 3], bf, acc[i][mt]); }
            } }
    }
    const float fbv = fbias[c];
#pragma unroll
    for (int i = 0; i < NTW; ++i) { const int j = wave + 8 * i, t1 = T1PT * j + t1l;
#pragma unroll
        for (int mt = 0; mt < 2; ++mt)
#pragma unroll
            for (int g = 0; g < 4; ++g) { const int t0 = 32 * mt + 8 * g + 4 * hh;
                const u32x2 vv = *(const LAS u32x2*)(Vl + ((t1 + PAD) * B + bcol) * 144 + 2 * t0);
                const size_t go = (size_t)bcol * 512 * L + 64 * t1 + t0;
                const u32x2 xv = *(const u32x2*)(xch + go);
                const float y0 = (acc[i][mt][4 * g + 0] + fbv * bflo(vv.x)) * bflo(xv.x), y1 = (acc[i][mt][4 * g + 1] + fbv * bfhi(vv.x)) * bfhi(xv.x);
                const float y2 = (acc[i][mt][4 * g + 2] + fbv * bflo(vv.y)) * bflo(xv.y), y3 = (acc[i][mt][4 * g + 3] + fbv * bfhi(vv.y)) * bfhi(xv.y);
                u32x2 w; w.x = pk2(y0, y1); w.y = pk2(y2, y3);
                *(u32x2*)(vch + go) = w; } }
    __syncthreads();
}

__device__ __forceinline__ void hynorm_unit(const bf16_t* hyT, const float* g_hy, bf16_t* merged, LAS unsigned char* lds, int u, int tid, int wave, int lane) {
    const int tok0 = 64 * u; int L, s_tile, seqbase;
    if (u < 512) { L = 2048; s_tile = (u & 31) * 64; seqbase = (u >> 5) * 2048; } else { const int v = u - 512; L = 4096; s_tile = (v & 63) * 64; seqbase = TOK_P + (v >> 6) * 4096; }
    LAS unsigned char* HL = lds;
    LAS float* ssq = (LAS float*)(lds + 512 * 144);
    const size_t ibase = (size_t)512 * seqbase + s_tile;
    for (int it = tid; it < 512 * 8; it += 512) { const int row = it >> 3, ch = it & 7;
        *(LAS u32x4*)(HL + row * 144 + 16 * ch) = *(const u32x4*)(hyT + ibase + (size_t)row * L + 8 * ch); }
    __syncthreads();
    float ss = 0.f;
    const LAS unsigned short* col = (const LAS unsigned short*)(HL + (64 * wave) * 144) + lane;
#pragma unroll 8
    for (int k = 0; k < 64; ++k) { const float v = bf2f(col[k * 72]); ss += v * v; }
    ssq[wave * 64 + lane] = ss;
    __syncthreads();
    float tot = 0.f;
#pragma unroll
    for (int w = 0; w < 8; ++w) tot += ssq[w * 64 + lane];
    const float rs = 1.0f / sqrtf(tot * (1.0f / 512.0f) + RMS_EPS_F);
    bf16_t* orow = merged + (size_t)(tok0 + lane) * DM + 512 + 64 * wave;
#pragma unroll
    for (int k8 = 0; k8 < 8; ++k8) { float v[8];
#pragma unroll
        for (int e = 0; e < 8; ++e) v[e] = bf2f(col[(8 * k8 + e) * 72]) * rs * g_hy[64 * wave + 8 * k8 + e];
        u32x4 w; w.x = pk2(v[0], v[1]); w.y = pk2(v[2], v[3]); w.z = pk2(v[4], v[5]); w.w = pk2(v[6], v[7]);
        *(u32x4*)(orow + 8 * k8) = w; }
    __syncthreads();
}

__device__ __forceinline__ void ln_rows(float* io, bf16_t* ob, const float* g, const float* b, int gw, int NGW, int lane) {
    f32x4 gv[4], bv[4];
#pragma unroll
    for (int j = 0; j < 4; ++j) { gv[j] = ((const f32x4*)g)[lane + 64 * j]; bv[j] = ((const f32x4*)b)[lane + 64 * j]; }
    for (int m = gw; m < T_TOK; m += NGW) {
        f32x4* xr = (f32x4*)(io + (size_t)m * DM) + lane;
        f32x4 v[4]; float s = 0.f;
#pragma unroll
        for (int j = 0; j < 4; ++j) { v[j] = xr[64 * j]; s += (v[j].x + v[j].y) + (v[j].z + v[j].w); }
        const float mean = wave_sum(s) * (1.f / DM); float s2 = 0.f;
#pragma unroll
        for (int j = 0; j < 4; ++j) { v[j] = v[j] - mean; s2 += (v[j].x * v[j].x + v[j].y * v[j].y) + (v[j].z * v[j].z + v[j].w * v[j].w); }
        const float rstd = 1.f / sqrtf(wave_sum(s2) * (1.f / DM) + LN_EPS_F);
#pragma unroll
        for (int j = 0; j < 4; ++j) { const f32x4 y = v[j] * rstd * gv[j] + bv[j]; xr[64 * j] = y;
            if (ob) { u32x2 w; w.x = pk2(y.x, y.y); w.y = pk2(y.z, y.w); ((u32x2*)(ob + (size_t)m * DM))[lane + 64 * j] = w; } }
    }
}

__device__ __forceinline__ void convgelu_chunk(const bf16_t* U, bf16_t* H, const float* cw, const float* cb, int L, int gtid, int nthreads) {
    constexpr int NG = DFF / 4, RUN = 16;
    const int nitems = (CHUNK / RUN) * NG;
    for (int it = gtid; it < nitems; it += nthreads) {
        const int g = it % NG, run = it / NG, c = 4 * g, t0 = run * RUN, s0 = t0 % L;
        f32x4 wa[3], wg[3];
#pragma unroll
        for (int k = 0; k < 3; ++k) { wa[k] = *(const f32x4*)(cw + k * NFF + c); wg[k] = *(const f32x4*)(cw + k * NFF + DFF + c); }
        const f32x4 ba = *(const f32x4*)(cb + c), bg = *(const f32x4*)(cb + DFF + c);
        const bf16_t* ua = U + (size_t)t0 * NFF + c; const bf16_t* ug = ua + DFF;
        f32x4 pa, pg, ca, cg_, na, ng;
        { u32x2 a = {0u, 0u}, b = {0u, 0u}; if (s0 > 0) { a = *(const u32x2*)(ua - NFF); b = *(const u32x2*)(ug - NFF); }
          pa = (f32x4){bflo(a.x), bfhi(a.x), bflo(a.y), bfhi(a.y)}; pg = (f32x4){bflo(b.x), bfhi(b.x), bflo(b.y), bfhi(b.y)};
          a = *(const u32x2*)(ua); b = *(const u32x2*)(ug);
          ca = (f32x4){bflo(a.x), bfhi(a.x), bflo(a.y), bfhi(a.y)}; cg_ = (f32x4){bflo(b.x), bfhi(b.x), bflo(b.y), bfhi(b.y)}; }
#pragma unroll 4
        for (int i = 0; i < RUN; ++i) {
            u32x2 a = {0u, 0u}, b = {0u, 0u}; if (s0 + i + 1 < L) { a = *(const u32x2*)(ua + (size_t)(i + 1) * NFF); b = *(const u32x2*)(ug + (size_t)(i + 1) * NFF); }
            na = (f32x4){bflo(a.x), bfhi(a.x), bflo(a.y), bfhi(a.y)}; ng = (f32x4){bflo(b.x), bfhi(b.x), bflo(b.y), bfhi(b.y)};
            const f32x4 va = wa[0] * pa + wa[1] * ca + wa[2] * na + ba, vg = wg[0] * pg + wg[1] * cg_ + wg[2] * ng + bg;
            const pg8::f32x2 g01 = pg8::gelu_pk((pg8::f32x2){vg[0], vg[1]}), g23 = pg8::gelu_pk((pg8::f32x2){vg[2], vg[3]});
            const f32x4 hv = va * (f32x4){g01.x, g01.y, g23.x, g23.y};
            u32x2 w; w.x = pk2(hv[0], hv[1]); w.y = pk2(hv[2], hv[3]);
            *(u32x2*)(H + (size_t)(t0 + i) * DFF + c) = w;
            pa = ca; pg = cg_; ca = na; cg_ = ng;
        }
    }
}

constexpr int NPHASE = 15;
__global__ void __launch_bounds__(512) fwd_kernel(Args A) {
    extern __shared__ __attribute__((aligned(16))) unsigned char lds_raw[];
    LAS unsigned char* lds = (LAS unsigned char*)lds_raw;
    cg::grid_group grid = cg::this_grid();
    const int tid = threadIdx.x, lane = tid & 63, wave = __builtin_amdgcn_readfirstlane(tid >> 6);
    const int bx = blockIdx.x, G = gridDim.x;
    unsigned char* ws = A.ws;
    bf16_t* xb = (bf16_t*)(ws + WS_XB); bf16_t* merged = xb;
    bf16_t* proj = (bf16_t*)(ws + WS_PROJ);
    bf16_t* vT = (bf16_t*)A.out; bf16_t* x0T = vT + (size_t)T_TOK * HYW;
    bf16_t* x1b = (bf16_t*)(ws + WS_X1B); bf16_t* ubuf = (bf16_t*)(ws + WS_U); bf16_t* hbuf = (bf16_t*)(ws + WS_HID);
    const int lo = A.ph_lo, hi = A.ph_hi;
#ifndef PHASE_MASK
#define PHASE_MASK 0x7fff
#endif
#define IN(k) (((PHASE_MASK >> (k)) & 1) && lo <= (k) && (k) < hi)
#define SEAM(k) do { if (IN(k) && IN((k) + 1)) grid.sync(); } while (0)
    if (IN(0)) { p0_prologue(A, lds, tid, wave, lane); }
    SEAM(0);
    if (IN(1)) { pg8::Gemm g{xb, (const bf16_t*)(ws + WS_WIN), T_TOK, NPROJ, DM}; pg8::StaticOrder S; S.init(T_TOK, NPROJ, G, bx);
        pg8::EpiBf16<0> E{proj, NPROJ, nullptr, 0, 0, 1.f};
        pg8::gemm_phase<pg8::EpiBf16<0>, pg8::StaticOrder, true, true>(lds, g, S, E); }
    SEAM(1);
    if (IN(2)) {
        for (int u = bx; u < 768; u += G) attn_unit(proj, A.in[I_RPB], A.in[I_GA], merged, lds, u, wave, lane);
        for (int u = bx; u < 768; u += G) hyprep_unit(proj, A.in[I_SW], A.in[I_SB], vT, x0T, lds, u, tid);
    }
    SEAM(2);
    if (IN(3)) {
        for (int u = bx; u < 1024; u += G) {
            if (u < 512) toeplitz_unit<L_P, 16>((const bf16_t*)(ws + WS_FILT_P), vT, x0T, A.in[I_FBIAS], lds, u, 0, tid, wave, lane);
            else toeplitz_unit<L_S, 4>((const bf16_t*)(ws + WS_FILT_S), vT, x0T, A.in[I_FBIAS], lds, u - 512, (size_t)512 * TOK_P, tid, wave, lane);
        }
    }
    SEAM(3);
    if (IN(4)) { for (int u = bx; u < 768; u += G) hynorm_unit(vT, A.in[I_GH], merged, lds, u, tid, wave, lane); }
    SEAM(4);
    if (IN(5)) {
        { pg8::Gemm g{merged, (const bf16_t*)(ws + WS_WOUT), TOK_P, DM, DM}; pg8::StaticOrder S; S.init(TOK_P, DM, G, bx);
          pg8::EpiAxpyF32 E{A.in[I_XP], A.out, DM, ALPHA_F};
          pg8::gemm_phase<pg8::EpiAxpyF32, pg8::StaticOrder, true, true>(lds, g, S, E); }
        { pg8::Gemm g{merged + (size_t)TOK_P * DM, (const bf16_t*)(ws + WS_WOUT), T_TOK - TOK_P, DM, DM}; pg8::StaticOrder S; S.init(T_TOK - TOK_P, DM, G, bx);
          pg8::EpiAxpyF32 E{A.in[I_XS], A.out + (size_t)TOK_P * DM, DM, ALPHA_F};
          pg8::gemm_phase<pg8::EpiAxpyF32, pg8::StaticOrder, true, true>(lds, g, S, E); }
    }
    SEAM(5);
    if (IN(6)) ln_rows(A.out, x1b, A.in[I_LN1G], A.in[I_LN1B], bx * 8 + wave, G * 8, lane);
    SEAM(6);
#pragma unroll
    for (int k = 0; k < NCHUNK + 1; ++k) {
        const int ph = 7 + 2 * k;
        if (IN(ph)) {
            if (k >= 1) { pg8::Gemm g{hbuf, (const bf16_t*)(ws + WS_WF2), CHUNK, DM, DFF}; pg8::StaticOrder S; S.init(CHUNK, DM, G, bx);
                float* o = A.out + (size_t)(k - 1) * CHUNK * DM; pg8::EpiAxpyF32 E{o, o, DM, ALPHA_F};
                pg8::gemm_phase<pg8::EpiAxpyF32, pg8::StaticOrder, true, true>(lds, g, S, E); }
            if (k < NCHUNK) { pg8::Gemm g{x1b + (size_t)k * CHUNK * DM, (const bf16_t*)(ws + WS_WF1), CHUNK, NFF, DM}; pg8::StaticOrder S; S.init(CHUNK, NFF, G, bx);
                pg8::EpiBf16<0> E{ubuf, NFF, nullptr, 0, 0, 1.f};
                pg8::gemm_phase<pg8::EpiBf16<0>, pg8::StaticOrder, true, true>(lds, g, S, E); }
        }
        SEAM(ph);
        if (k < NCHUNK) {
            if (IN(ph + 1)) convgelu_chunk(ubuf, hbuf, A.in[I_FFCW], A.in[I_FFCB], k < 2 ? L_P : L_S, bx * 512 + tid, G * 512);
            SEAM(ph + 1);
        }
    }
    if (IN(14)) ln_rows(A.out, nullptr, A.in[I_LN2G], A.in[I_LN2B], bx * 8 + wave, G * 8, lane);
#undef IN
#undef SEAM
}

#ifndef MK_PER_PHASE
#define MK_PER_PHASE 0
#endif
extern "C" void kernel_launch(void* const* d_in, const int* in_sizes, int n_in, void* d_out, int out_size, void* d_ws, size_t ws_size, hipStream_t stream) {
    static int grid = 0;
    if (grid == 0) {
        if (n_in != 24 || out_size != T_TOK * DM || ws_size < WS_NEED) { fprintf(stderr, "kernel_launch: unexpected shapes n_in %d out %d ws %zu\n", n_in, out_size, ws_size); grid = -1; return; }
        int dev = 0, cus = 0, per_cu = 0;
        hipGetDevice(&dev); hipDeviceGetAttribute(&cus, hipDeviceAttributeMultiprocessorCount, dev);
        if (hipFuncSetAttribute((const void*)fwd_kernel, hipFuncAttributeMaxDynamicSharedMemorySize, LDS_BYTES) != hipSuccess) { fprintf(stderr, "hipFuncSetAttribute failed\n"); grid = -1; return; }
        if (hipOccupancyMaxActiveBlocksPerMultiprocessor(&per_cu, (const void*)fwd_kernel, 512, LDS_BYTES) != hipSuccess || per_cu < 1) { fprintf(stderr, "occupancy query: %d\n", per_cu); per_cu = 1; }
        (void)hipGetLastError();
        grid = cus * 1;
        fprintf(stderr, "kernel_launch: grid %d (cus %d, per_cu %d) ws %zu\n", grid, cus, per_cu, ws_size);
    }
    if (grid < 0) return;
    Args a{};
    for (int i = 0; i < 24; ++i) a.in[i] = (const float*)d_in[i];
    a.out = (float*)d_out; a.ws = (unsigned char*)d_ws;
#if MK_PER_PHASE
    for (int p = 0; p < NPHASE; ++p) { a.ph_lo = p; a.ph_hi = p + 1; hipLaunchKernelGGL(fwd_kernel, dim3(grid), dim3(512), LDS_BYTES, stream, a); }
#else
    a.ph_lo = 0; a.ph_hi = NPHASE;
    void* args[] = {&a};
    hipError_t e = hipLaunchCooperativeKernel((const void*)fwd_kernel, dim3(grid), dim3(512), args, LDS_BYTES, stream);
    if (e != hipSuccess) fprintf(stderr, "cooperative launch failed: %s (grid %d)\n", hipGetErrorString(e), grid);
#endif
}
```

```cpp
#include <hip/hip_runtime.h>
#include <hip/hip_cooperative_groups.h>
#include <cstdio>
#include <cstdint>
namespace cg = cooperative_groups;
namespace pg8 {
#define PG8_LAS __attribute__((address_space(3)))
typedef unsigned short bf16_t;
typedef short bf16x8 __attribute__((ext_vector_type(8)));
typedef float f32x4 __attribute__((ext_vector_type(4)));
typedef unsigned u32x4 __attribute__((ext_vector_type(4)));
constexpr int BM = 256, BK = 64, HALF = 128, HTB = HALF * BK * 2  , STAGE_BYTES = 8 * HTB, NXCD = 8, WGM = 8;

__host__ __device__ __forceinline__ int lds_byte(int r, int c) { const int st = (r >> 4) * 2 + (c >> 5), rr = r & 15, cc = c & 31, ob = rr * 64 + cc * 2; return st * 1024 + (ob ^ (((ob >> 9) & 1) << 5)); }
__host__ __device__ __forceinline__ void stage_rc(int b, int& R, int& C) { const int st = b / 1024, sb = b % 1024, swz = sb ^ (((sb >> 9) & 1) << 5); R = (st >> 1) * 16 + swz / 64; C = (st & 1) * 32 + (swz % 64) / 2; }
__host__ __device__ __forceinline__ int perm32(int rho) { const int n = rho >> 4, i = rho & 15; return 8 * (i >> 2) + 4 * n + (i & 3); }

struct Unit { int pm, pn; };
struct Gemm { const bf16_t* A; const bf16_t* Bt; int M, N, K; };

struct StaticOrder {
    int nM, nN, nwg, G, c;
    __host__ __device__ void init(int M, int N, int G_, int c_) { nM = M / BM; nN = N / BM; nwg = nM * nN; G = G_; c = c_; }
    __host__ __device__ bool next(int i, Unit& u) const {
        const long L = (long)i * G + c; if (L >= nwg) return false;
        int wgid = (int)L; { const int q = nwg / NXCD, r = nwg % NXCD, xcd = wgid % NXCD, off = wgid / NXCD; wgid = (xcd < r ? xcd * (q + 1) : r * (q + 1) + (xcd - r) * q) + off; }
        const int nig = WGM * nN, gid = wgid / nig, fm = gid * WGM, gsz = (nM - fm) < WGM ? (nM - fm) : WGM;
        u.pm = fm + ((wgid % nig) % gsz); u.pn = (wgid % nig) / gsz; return true;
    }
    __device__ __forceinline__ void a_ready(const Unit&) const {}
    __device__ __forceinline__ void done(const Unit&) const {}
};

__device__ __forceinline__ unsigned cvt_pk_bf16(float lo, float hi) { unsigned r; asm volatile("v_cvt_pk_bf16_f32 %0, %1, %2" : "=v"(r) : "v"(lo), "v"(hi)); return r; }
typedef float f32x2 __attribute__((ext_vector_type(2)));
__device__ __forceinline__ f32x2 gelu_pk(f32x2 v) {
    const f32x2 av = __builtin_elementwise_abs(v), d = av * 0.2316418882f + 1.0f;
    f32x2 t; t.x = __builtin_amdgcn_rcpf(d.x); t.y = __builtin_amdgcn_rcpf(d.y);
    f32x2 q = t * 0.5307027145f + (-0.7265760135f); q = q * t + 0.7107068705f; q = q * t + (-0.142248368f); q = q * t + 0.127414796f; q = q * t;
    const f32x2 s = (v * v) * (-0.72134752044f);
    f32x2 e; e.x = __builtin_amdgcn_exp2f(s.x); e.y = __builtin_amdgcn_exp2f(s.y);
    const f32x2 m = v * (q * e), r = v - m;
    f32x2 o; o.x = v.x < 0.f ? m.x : r.x; o.y = v.y < 0.f ? m.y : r.y; return o;
}

template <int ACT  > struct EpiBf16 {
    static constexpr bool PERM = true, AFTER_DRAIN = false; static_assert(ACT == 0 || ACT == 1, "EpiBf16: ACT is 0 (none) or 1 (gelu_pk)");
    bf16_t* O; int ldc; const float* bias; int split_cols; size_t split_stride; float scale0;
    __device__ __forceinline__ void operator()(const f32x4 (&acc)[2][2][4][2], const Unit& u, int wr, int wc, int fr, int fq) const {
        const int row0 = u.pm * BM + wr * 64 + fr; int colt = u.pn * BM; bf16_t* base = O;
        float sc = 1.f; if (split_cols) { const int t = colt / split_cols; base += (size_t)t * split_stride; colt -= t * split_cols; if (t == 0) sc = scale0; }
        const int col0 = colt + wc * 32 + 8 * fq, bcol0 = u.pn * BM + wc * 32 + 8 * fq;
        f32x4 bv[2][2];
#pragma unroll
        for (int bj = 0; bj < 2; ++bj)
#pragma unroll
            for (int n = 0; n < 2; ++n) bv[bj][n] = bias ? *(const f32x4*)(bias + bcol0 + bj * HALF + 4 * n) : (f32x4){0.f, 0.f, 0.f, 0.f};
#pragma unroll
        for (int ai = 0; ai < 2; ++ai)
#pragma unroll
            for (int m = 0; m < 4; ++m) { bf16_t* rowp = base + (size_t)(row0 + ai * HALF + m * 16) * ldc + col0;
#pragma unroll
                for (int bj = 0; bj < 2; ++bj) { f32x4 v0 = acc[ai][bj][m][0] + bv[bj][0], v1 = acc[ai][bj][m][1] + bv[bj][1];
                    if (ACT == 1) { f32x2 a = gelu_pk((f32x2){v0[0], v0[1]}), b = gelu_pk((f32x2){v0[2], v0[3]}), c = gelu_pk((f32x2){v1[0], v1[1]}), d = gelu_pk((f32x2){v1[2], v1[3]});
                        v0 = (f32x4){a.x, a.y, b.x, b.y}; v1 = (f32x4){c.x, c.y, d.x, d.y}; }
                    v0 = v0 * sc; v1 = v1 * sc; u32x4 w; w.x = cvt_pk_bf16(v0[0], v0[1]); w.y = cvt_pk_bf16(v0[2], v0[3]); w.z = cvt_pk_bf16(v1[0], v1[1]); w.w = cvt_pk_bf16(v1[2], v1[3]);
                    *(u32x4*)(rowp + bj * HALF) = w; } }
    }
};
template <class Epi, class Sched, bool ALIGN_EPI = false, bool SP2 = false>
__device__ __forceinline__ void gemm_phase(PG8_LAS unsigned char* lds, const Gemm g, const Sched& S, const Epi& E) {
    const int tid = threadIdx.x, wid = __builtin_amdgcn_readfirstlane(tid >> 6), lane = tid & 63, wr = wid >> 2, wc = wid & 3, fr = lane & 15, fq = lane >> 4;
    const int K = g.K, nt = K / BK;
    unsigned voffA[2], voffB[2];
#pragma unroll
    for (int i = 0; i < 2; ++i) { int R, C; stage_rc(tid * 16 + i * 8192, R, C); const int Rb = Epi::PERM ? ((R & ~31) + perm32(R & 31)) : R;
        voffA[i] = (unsigned)(R * K + C) * 2u; voffB[i] = (unsigned)(Rb * K + C) * 2u; }
    const size_t kstep = (size_t)(BK * 2);
    const size_t hstep = (size_t)HALF * K * 2;
    const size_t tstep = 2 * hstep;
    const unsigned ldsw = (unsigned)wid * 1024u;
    const int aoff = lds_byte(wr * 64 + fr, fq * 8), boff = lds_byte(wc * 32 + fr, fq * 8);
#define PG8_SA(b, h) (((b) * 2 + (h)) * HTB)
#define PG8_SB(b, h) ((4 + (b) * 2 + (h)) * HTB)
#define PG8_STAGE(bufoff, gbase, voff) do { _Pragma("unroll") for (int _i = 0; _i < 2; ++_i) \
        __builtin_amdgcn_global_load_lds((const unsigned*)((const char*)(gbase) + (voff)[_i]), (PG8_LAS unsigned*)(lds + (bufoff) + ldsw + _i * 8192), 16, 0, 0); } while (0)
#define PG8_LDA(dst, b, h) do { _Pragma("unroll") for (int m = 0; m < 4; ++m) _Pragma("unroll") for (int k = 0; k < 2; ++k) dst[m][k] = *(const PG8_LAS bf16x8*)(lds + PG8_SA(b, h) + aoff + m * 2048 + k * 1024); } while (0)
#define PG8_LDB(dst, b, h) do { _Pragma("unroll") for (int n = 0; n < 2; ++n) _Pragma("unroll") for (int k = 0; k < 2; ++k) dst[n][k] = *(const PG8_LAS bf16x8*)(lds + PG8_SB(b, h) + boff + n * 2048 + k * 1024); } while (0)
#define PG8_MMA(ai, bj, At, Bt) do { __builtin_amdgcn_s_setprio(1); _Pragma("unroll") for (int m = 0; m < 4; ++m) _Pragma("unroll") for (int n = 0; n < 2; ++n) _Pragma("unroll") for (int k = 0; k < 2; ++k) \
        acc[ai][bj][m][n] = __builtin_amdgcn_mfma_f32_16x16x32_bf16(Bt[n][k], At[m][k], acc[ai][bj][m][n], 0, 0, 0); __builtin_amdgcn_s_setprio(0); } while (0)
#define PG8_WAIT_V(n) asm volatile("s_waitcnt vmcnt(" #n ")" ::: "memory")
#define PG8_WAIT_L(n) asm volatile("s_waitcnt lgkmcnt(" #n ")" ::: "memory")
#define PG8_BAR __builtin_amdgcn_s_barrier()
#define PG8_SCHED __builtin_amdgcn_sched_barrier(0)
    Unit cur, nxt; int ui = 0;
    if (!S.next(0, cur)) return;
    f32x4 acc[2][2][4][2];
#pragma unroll
    for (int a = 0; a < 2; ++a)
#pragma unroll
        for (int b = 0; b < 2; ++b)
#pragma unroll
            for (int m = 0; m < 4; ++m)
#pragma unroll
                for (int n = 0; n < 2; ++n) acc[a][b][m][n] = (f32x4){0.f, 0.f, 0.f, 0.f};
    bf16x8 At[4][2], B0[2][2], B1[2][2];
    const char* cA = (const char*)g.A + (size_t)cur.pm * tstep; const char* cB = (const char*)g.Bt + (size_t)cur.pn * tstep;
    S.a_ready(cur);
    if constexpr (SP2) {
        PG8_STAGE(PG8_SB(0, 0), cB, voffB); PG8_STAGE(PG8_SB(0, 1), cB + hstep, voffB); PG8_STAGE(PG8_SA(0, 0), cA, voffA); PG8_STAGE(PG8_SA(0, 1), cA + hstep, voffA);
        if (wr == 1) PG8_BAR;
        PG8_WAIT_V(2); PG8_BAR;
        PG8_STAGE(PG8_SB(1, 0), cB + kstep, voffB); PG8_STAGE(PG8_SA(1, 0), cA + kstep, voffA); PG8_STAGE(PG8_SB(1, 1), cB + hstep + kstep, voffB);
        PG8_WAIT_V(6); PG8_BAR;
    } else {
        PG8_STAGE(PG8_SB(0, 0), cB, voffB); PG8_STAGE(PG8_SA(0, 0), cA, voffA); PG8_STAGE(PG8_SB(0, 1), cB + hstep, voffB); PG8_STAGE(PG8_SA(0, 1), cA + hstep, voffA);
        if (wr == 1) PG8_BAR;
        PG8_WAIT_V(4); PG8_BAR;
        PG8_STAGE(PG8_SB(1, 0), cB + kstep, voffB); PG8_STAGE(PG8_SA(1, 0), cA + kstep, voffA); PG8_STAGE(PG8_SB(1, 1), cB + hstep + kstep, voffB);
        PG8_WAIT_V(6); PG8_BAR;
    }
    for (;;) {
        const bool has_next = S.next(ui + 1, nxt);
        const char* nA = has_next ? (const char*)g.A + (size_t)nxt.pm * tstep : cA; const char* nB = has_next ? (const char*)g.Bt + (size_t)nxt.pn * tstep : cB;
        for (int t = 0; t < nt; t += 2) {
            const bool last = (t == nt - 2);
            const char* a1 = cA + (size_t)(t + 1) * kstep;
            const char* a2 = last ? nA : cA + (size_t)(t + 2) * kstep; const char* b2 = last ? nB : cB + (size_t)(t + 2) * kstep;
            const char* a3 = a2 + kstep; const char* b3 = b2 + kstep;
            if (last && has_next) S.a_ready(nxt);
            if constexpr (SP2) {
            PG8_LDB(B0, 0, 0); PG8_LDB(B1, 0, 1); PG8_SCHED; PG8_LDA(At, 0, 0); PG8_STAGE(PG8_SA(1, 1), a1 + hstep, voffA);
            PG8_WAIT_V(8); PG8_WAIT_L(0); PG8_BAR; PG8_MMA(0, 0, At, B0); PG8_MMA(0, 1, At, B1); PG8_BAR; PG8_SCHED;
            PG8_LDA(At, 0, 1); PG8_STAGE(PG8_SB(0, 0), b2, voffB); PG8_STAGE(PG8_SB(0, 1), b2 + hstep, voffB); PG8_STAGE(PG8_SA(0, 0), a2, voffA);
            PG8_WAIT_V(8); PG8_WAIT_L(0); PG8_BAR; PG8_MMA(1, 0, At, B0); PG8_MMA(1, 1, At, B1); PG8_BAR; PG8_SCHED;
            PG8_LDB(B0, 1, 0); PG8_LDB(B1, 1, 1); PG8_SCHED; PG8_LDA(At, 1, 0); PG8_STAGE(PG8_SA(0, 1), a2 + hstep, voffA);
            PG8_WAIT_V(8); PG8_WAIT_L(0); PG8_BAR; PG8_MMA(0, 0, At, B0); PG8_MMA(0, 1, At, B1); PG8_BAR; PG8_SCHED;
            PG8_LDA(At, 1, 1); PG8_STAGE(PG8_SB(1, 0), b3, voffB); PG8_STAGE(PG8_SB(1, 1), b3 + hstep, voffB); PG8_STAGE(PG8_SA(1, 0), a3, voffA);
            PG8_WAIT_V(8); PG8_WAIT_L(0); PG8_BAR; PG8_MMA(1, 0, At, B0); PG8_MMA(1, 1, At, B1); PG8_BAR; PG8_SCHED;
            } else {
            PG8_LDB(B0, 0, 0); PG8_SCHED; PG8_LDA(At, 0, 0); PG8_STAGE(PG8_SA(1, 1), a1 + hstep, voffA);
            PG8_WAIT_L(8); PG8_BAR; PG8_WAIT_L(0); PG8_MMA(0, 0, At, B0); PG8_BAR; PG8_SCHED;
            PG8_LDB(B1, 0, 1); PG8_STAGE(PG8_SB(0, 0), b2, voffB);
            PG8_BAR; PG8_WAIT_L(0); PG8_MMA(0, 1, At, B1); PG8_BAR;
            PG8_LDA(At, 0, 1); PG8_STAGE(PG8_SA(0, 0), a2, voffA);
            PG8_BAR; PG8_WAIT_L(0); PG8_MMA(1, 0, At, B0); PG8_BAR; PG8_SCHED;
            PG8_STAGE(PG8_SB(0, 1), b2 + hstep, voffB);
            PG8_WAIT_V(6); PG8_BAR; PG8_MMA(1, 1, At, B1); PG8_BAR;
            PG8_LDB(B0, 1, 0); PG8_SCHED; PG8_LDA(At, 1, 0); PG8_STAGE(PG8_SA(0, 1), a2 + hstep, voffA);
            PG8_WAIT_L(8); PG8_BAR; PG8_WAIT_L(0); PG8_MMA(0, 0, At, B0); PG8_BAR; PG8_SCHED;
            PG8_LDB(B1, 1, 1); PG8_STAGE(PG8_SB(1, 0), b3, voffB);
            PG8_BAR; PG8_WAIT_L(0); PG8_MMA(0, 1, At, B1); PG8_BAR;
            PG8_LDA(At, 1, 1); PG8_STAGE(PG8_SA(1, 0), a3, voffA);
            PG8_BAR; PG8_WAIT_L(0); PG8_MMA(1, 0, At, B0); PG8_BAR; PG8_SCHED;
            PG8_STAGE(PG8_SB(1, 1), b3 + hstep, voffB);
            PG8_WAIT_V(6); PG8_BAR; PG8_MMA(1, 1, At, B1); PG8_BAR;
            }
        }
        if constexpr (ALIGN_EPI) { if (wr == 0) PG8_BAR; }
        if constexpr (!Epi::AFTER_DRAIN) { E(acc, cur, wr, wc, fr, fq); S.done(cur); }
        if (!has_next) break;
#pragma unroll
        for (int a = 0; a < 2; ++a)
#pragma unroll
            for (int b = 0; b < 2; ++b)
#pragma unroll
                for (int m = 0; m < 4; ++m)
#pragma unroll
                    for (int n = 0; n < 2; ++n) acc[a][b][m][n] = (f32x4){0.f, 0.f, 0.f, 0.f};
        cur = nxt; cA = nA; cB = nB; ++ui;
        if constexpr (ALIGN_EPI) { if (wr == 1) PG8_BAR; }
    }
    PG8_WAIT_V(0);
    if constexpr (!ALIGN_EPI) { if (wr == 0) PG8_BAR; }
    PG8_BAR;
    if constexpr (Epi::AFTER_DRAIN) { E.fused(acc, cur, wr, wc, fr, fq, lds, wid, lane); S.done(cur); }
#undef PG8_SA
#undef PG8_SB
#undef PG8_STAGE
#undef PG8_LDA
#undef PG8_LDB
#undef PG8_MMA
#undef PG8_WAIT_V
#undef PG8_WAIT_L
#undef PG8_BAR
#undef PG8_SCHED
}
}
namespace pg8 {
struct EpiAxpyF32 {
    static constexpr bool PERM = false, AFTER_DRAIN = false;
    const float* base; float* out; int ldc; float alpha;
    __device__ __forceinline__ void operator()(const f32x4 (&acc)[2][2][4][2], const Unit& u, int wr, int wc, int fr, int fq) const {
        const int row0 = u.pm * BM + wr * 64 + fr, col0 = u.pn * BM + wc * 32 + 4 * fq;
#pragma unroll
        for (int ai = 0; ai < 2; ++ai)
#pragma unroll
            for (int m = 0; m < 4; ++m) { const size_t ro = (size_t)(row0 + ai * HALF + m * 16) * ldc + col0;
#pragma unroll
                for (int bj = 0; bj < 2; ++bj)
#pragma unroll
                    for (int n = 0; n < 2; ++n) { const size_t off = ro + bj * HALF + n * 16; const f32x4 b = *(const f32x4*)(base + off); *(f32x4*)(out + off) = b * alpha + acc[ai][bj][m][n]; } }
    }
};
}

#define LAS __attribute__((address_space(3)))
typedef unsigned short bf16_t;
typedef short bf16x8 __attribute__((ext_vector_type(8)));
typedef short s16x4 __attribute__((ext_vector_type(4)));
typedef float f32x2 __attribute__((ext_vector_type(2)));
typedef float f32x4 __attribute__((ext_vector_type(4)));
typedef float f32x16 __attribute__((ext_vector_type(16)));
typedef unsigned u32x2 __attribute__((ext_vector_type(2)));
typedef unsigned u32x4 __attribute__((ext_vector_type(4)));
typedef __bf16 bf16x2v __attribute__((ext_vector_type(2)));

constexpr int T_TOK = 49152, DM = 1024, NPROJ = 3072, DFF = 2816, NFF = 5632, HYW = 512;
constexpr int L_P = 2048, L_S = 4096, TOK_P = 32768;
constexpr int CHUNK = 16384, NCHUNK = 3;
constexpr float ALPHA_F = 1.189207115002721f;
constexpr float LN_EPS_F = 1e-5f, RMS_EPS_F = 1e-6f;
constexpr size_t MiB = 1u << 20;
constexpr size_t WS_WIN = 2 * MiB, WS_WOUT = 8 * MiB, WS_WF1 = 10 * MiB, WS_WF2 = 22 * MiB;
constexpr size_t WS_FILT_P = 28 * MiB, WS_FILT_S = 36 * MiB;
constexpr size_t WS_XB = 52 * MiB;
constexpr size_t WS_PROJ = 148 * MiB;
constexpr size_t WS_X1B = 148 * MiB, WS_U = 244 * MiB, WS_HID = 420 * MiB;
constexpr size_t WS_NEED = 508 * MiB;
constexpr int LDS_BYTES = 147456;

__device__ __forceinline__ unsigned pk2(float a, float b) { f32x2 v = {a, b}; bf16x2v r = __builtin_convertvector(v, bf16x2v); return __builtin_bit_cast(unsigned, r); }
__device__ __forceinline__ float bf2f(unsigned short h) { return __builtin_bit_cast(float, (unsigned)h << 16); }
__device__ __forceinline__ float bflo(unsigned w) { return __builtin_bit_cast(float, w << 16); }
__device__ __forceinline__ float bfhi(unsigned w) { return __builtin_bit_cast(float, w & 0xffff0000u); }
#define MFMA32(a, b, c) __builtin_amdgcn_mfma_f32_32x32x16_bf16((a), (b), (c), 0, 0, 0)
#define LDS_WAIT() asm volatile("s_waitcnt lgkmcnt(0)" ::: "memory")
__device__ __forceinline__ int crow(int reg, int h) { return (reg & 3) + 8 * (reg >> 2) + 4 * h; }
__device__ __forceinline__ float sin_turns(float tr) { tr = tr - floorf(tr); return __builtin_amdgcn_sinf(tr); }
__device__ __forceinline__ float fast_sin(float x) { return sin_turns(x * 0.15915494309189535f); }
__device__ __forceinline__ float wave_sum(float v) {
#pragma unroll
    for (int o = 1; o < 64; o <<= 1) v += __shfl_xor(v, o);
    return v;
}

#define XB_TMO      128
#define XB_XCNT(j)  (256  + 64 * (j))
#define XB_XSUB(j)  (1280 + 64 * (j))
#define XB_XGEN(j)  (2304 + 64 * (j))
#define XB_TOP      3328
#define XB_TOPGEN   3392
#define XCD_BAR_WORDS 3456
#define XB_SPIN_CAP (1u << 18)

__device__ __forceinline__ unsigned xb_ld(unsigned* p)              { return __hip_atomic_load(p, __ATOMIC_RELAXED, __HIP_MEMORY_SCOPE_AGENT); }
__device__ __forceinline__ unsigned xb_add(unsigned* p, unsigned v) { return __hip_atomic_fetch_add(p, v, __ATOMIC_RELAXED, __HIP_MEMORY_SCOPE_AGENT); }
__device__ __forceinline__ unsigned xb_xcc_id() { return (unsigned)__builtin_amdgcn_s_getreg((3 << 11) | 20) & 0xFu; }
#define XB_SPIN(cond, bar) do { unsigned _sp = 0; while (cond) { __builtin_amdgcn_s_sleep(1); \
    if ((++_sp & 255u) == 0u) { if (xb_ld(&(bar)[XB_TMO])) break; if (_sp > XB_SPIN_CAP) { atomicAdd(&(bar)[XB_TMO], 1u); break; } } } } while (0)

struct XcdBarrier {
    unsigned* bar; unsigned x;
    volatile LAS unsigned* st;
};

__device__ __forceinline__ XcdBarrier xcd_barrier_post(unsigned* bar, volatile LAS unsigned* st) {
    XcdBarrier b; b.bar = bar; b.x = xb_xcc_id(); b.st = st;
    if (threadIdx.x == 0) (void)xb_add(&bar[XB_XCNT(b.x)], 1u);
    return b;
}
__device__ __forceinline__ void xcd_barrier_complete(unsigned* bar, unsigned x, unsigned& nloc, unsigned& nx) {
    const unsigned G = gridDim.x * gridDim.y * gridDim.z;
    unsigned sum, cnt, mine, sp = 0u;
    for (;;) {
        sum = 0u; cnt = 0u; mine = 0u;
#pragma unroll
        for (unsigned j = 0; j < 16; ++j) { const unsigned c = xb_ld(&bar[XB_XCNT(j)]); sum += c; cnt += (c > 0u) ? 1u : 0u; mine = (j == x) ? c : mine; }
        if (sum == G) break;
        __builtin_amdgcn_s_sleep(1);
        if ((++sp & 255u) == 0u) { if (xb_ld(&bar[XB_TMO])) break; if (sp > XB_SPIN_CAP) { atomicAdd(&bar[XB_TMO], 1u); break; } }
    }
    nloc = mine > 0u ? mine : 1u; nx = cnt > 0u ? cnt : 1u;
}

__device__ __forceinline__ void xcd_barrier(const XcdBarrier& b) {
    asm volatile("s_waitcnt vmcnt(0)" ::: "memory");
    __syncthreads();
    if (threadIdx.x == 0) {
        unsigned* bar = b.bar;
        __builtin_amdgcn_s_waitcnt(0);
        unsigned nloc = b.st[0], nx = b.st[1];
        if (nloc == 0u) { xcd_barrier_complete(bar, b.x, nloc, nx); b.st[0] = nloc; b.st[1] = nx; }
        const unsigned old = xb_add(&bar[XB_XSUB(b.x)], 1u);
        const unsigned gen = old / nloc;
        if (old + 1u == (gen + 1u) * nloc) {
            __builtin_amdgcn_fence(__ATOMIC_RELEASE, "agent");
            asm volatile("s_waitcnt vmcnt(0)" ::: "memory");
            const unsigned og = xb_add(&bar[XB_TOP], 1u);
            const unsigned tg = og / nx;
            if (og + 1u == (tg + 1u) * nx) xb_add(&bar[XB_TOPGEN], 1u);
            else XB_SPIN(xb_ld(&bar[XB_TOPGEN]) == tg, bar);
            __builtin_amdgcn_fence(__ATOMIC_ACQUIRE, "agent");
            xb_add(&bar[XB_XGEN(b.x)], 1u);
            asm volatile("s_waitcnt vmcnt(0)" ::: "memory");
        } else {
            XB_SPIN(xb_ld(&bar[XB_XGEN(b.x)]) == gen, bar);
            __builtin_amdgcn_fence(__ATOMIC_ACQUIRE, "agent");
            asm volatile("s_waitcnt vmcnt(0)" ::: "memory");
        }
    }
    __syncthreads();
}

struct Args { const float* in[24]; float* out; unsigned char* ws; int ph_lo, ph_hi, li, pad; };
enum { I_XP = 0, I_XS, I_WIN, I_SW, I_SB, I_RPB, I_FW1, I_FB1, I_FFREQ, I_FWI, I_FBI, I_FW3, I_FBIAS, I_GA, I_GH, I_WOUT, I_LN1G, I_LN1B, I_FFW1, I_FFCW, I_FFCB, I_FFW2, I_LN2G, I_LN2B };

__device__ __forceinline__ void p0_transpose_item(const float* W, int K, int N, bf16_t* WT, LAS float* scr, int item, int lane) {
    const int nblk = N / 32, kb = item / nblk, nb = item % nblk, k0 = 64 * kb, n0 = 32 * nb;
#pragma unroll 8
    for (int i = 0; i < 32; ++i) { const int kk = 2 * i + (lane >> 5); scr[kk * 33 + (lane & 31)] = W[(size_t)(k0 + kk) * N + n0 + (lane & 31)]; }
    LDS_WAIT();
    const int c = lane & 7;
#pragma unroll
    for (int j = 0; j < 4; ++j) { const int n = (lane >> 3) + 8 * j; const LAS float* s = scr + (8 * c) * 33 + n;
        u32x4 o; o.x = pk2(s[0 * 33], s[1 * 33]); o.y = pk2(s[2 * 33], s[3 * 33]); o.z = pk2(s[4 * 33], s[5 * 33]); o.w = pk2(s[6 * 33], s[7 * 33]);
        *(u32x4*)(WT + (size_t)(n0 + n) * K + k0 + 8 * c) = o; }
    LDS_WAIT();
}

template <int L>
__device__ __forceinline__ void filter_unit(const Args& A, bf16_t* Rg, LAS unsigned char* lds, int chunk, int tid) {
    constexpr int NP = 8;
    LAS float* Z = (LAS float*)lds;
    LAS float* H1 = Z + NP * 36;
    LAS float* H2 = H1 + NP * 65;
    const float* w1 = A.in[I_FW1]; const float* b1 = A.in[I_FB1]; const float* fq = A.in[I_FFREQ];
    const float* wi = A.in[I_FWI]; const float* bi = A.in[I_FBI]; const float* w3 = A.in[I_FW3];
    const int t0 = chunk * NP;
    if (tid < NP * 33) {
        const int p = tid / 33, f = tid % 33, t = t0 + p; float val;
        if (f == 0) val = (float)t / (float)(L - 1);
        else { const int k = (f - 1) & 15; const float fr = 1e-4f + (float)k * ((15.0f - 1e-4f) / 15.0f); const float tr = ((float)t / (float)L) * fr; val = (f <= 16) ? sin_turns(tr + 0.25f) : -sin_turns(tr); }
        Z[p * 36 + f] = val;
    }
    __syncthreads();
    const int p_ = tid >> 6, j_ = tid & 63; const float fqj = fq[j_];
    { float a = b1[j_];
#pragma unroll 3
      for (int f = 0; f < 33; ++f) a += Z[p_ * 36 + f] * w1[f * 64 + j_];
      H1[p_ * 65 + j_] = fast_sin(fqj * a); }
    __syncthreads();
    { float a = bi[j_];
#pragma unroll 8
      for (int f = 0; f < 64; ++f) a += H1[p_ * 65 + f] * wi[f * 64 + j_];
      H2[p_ * 65 + j_] = fast_sin(fqj * a); }
    __syncthreads();
    { float a = bi[64 + j_];
#pragma unroll 8
      for (int f = 0; f < 64; ++f) a += H2[p_ * 65 + f] * wi[4096 + f * 64 + j_];
      H1[p_ * 65 + j_] = fast_sin(fqj * a); }
    __syncthreads();
    const int c = tid;
    float af[NP], ab[NP];
#pragma unroll
    for (int p = 0; p < NP; ++p) { af[p] = 0.f; ab[p] = 0.f; }
#pragma unroll 4
    for (int k = 0; k < 64; ++k) { const float wf = w3[k * 1024 + c], wb = w3[k * 1024 + 512 + c];
#pragma unroll
        for (int p = 0; p < NP; ++p) { const float h = H1[p * 65 + k]; af[p] += h * wf; ab[p] += h * wb; } }
    const float MIN_DECAY = -3.0701134573253945f, MAX_DECAY = -15.350567286626973f;
    const float delta = fabsf(MIN_DECAY + (float)c * ((MAX_DECAY - MIN_DECAY) / 511.0f));
    bf16_t* c0 = Rg + (size_t)c * (4 * L); bf16_t* c1 = c0 + 2 * L;
#pragma unroll
    for (int p = 0; p < NP; ++p) { const int t = t0 + p; const float tl = (float)t / (float)(L - 1); const float dec = __expf(-tl * delta);
        const bf16_t hf = (bf16_t)(pk2(af[p] * dec, 0.f) & 0xffffu), hb = (bf16_t)(pk2(ab[p] * dec, 0.f) & 0xffffu);
        c0[L - t] = hf; c1[L - t - 1] = hf;
        if (t >= 1) { c0[L + t] = hb; c1[L + t - 1] = hb; } else { c0[0] = 0; c1[2 * L - 1] = 0; } }
    __syncthreads();
}

__device__ __forceinline__ void p0_prologue(const Args& A, LAS unsigned char* lds, int tid, int wave, int lane) {
    unsigned char* ws = A.ws;
    const int bx = blockIdx.x, G = gridDim.x;
    for (int u = bx; u < 768; u += G) { if (u < 256) filter_unit<L_P>(A, (bf16_t*)(ws + WS_FILT_P), lds, u, tid); else filter_unit<L_S>(A, (bf16_t*)(ws + WS_FILT_S), lds, u - 256, tid); }
    __syncthreads();
    LAS float* scr = (LAS float*)(lds + wave * 16384);
    const int gw = bx * 8 + wave, NGW = G * 8;
    constexpr int I1 = 16 * 96, I2 = 16 * 32, I3 = 16 * 176, I4 = 44 * 32;
    for (int it = gw; it < I1 + I2 + I3 + I4; it += NGW) {
        int r = it;
        if (r < I1) { p0_transpose_item(A.in[I_WIN], 1024, 3072, (bf16_t*)(ws + WS_WIN), scr, r, lane); continue; } r -= I1;
        if (r < I2) { p0_transpose_item(A.in[I_WOUT], 1024, 1024, (bf16_t*)(ws + WS_WOUT), scr, r, lane); continue; } r -= I2;
        if (r < I3) { p0_transpose_item(A.in[I_FFW1], 1024, 5632, (bf16_t*)(ws + WS_WF1), scr, r, lane); continue; } r -= I3;
        p0_transpose_item(A.in[I_FFW2], 2816, 1024, (bf16_t*)(ws + WS_WF2), scr, r, lane);
    }
    bf16_t* xb = (bf16_t*)(ws + WS_XB);
    for (int m = gw; m < T_TOK; m += NGW) {
        const float* xr = (m < TOK_P) ? (A.in[I_XP] + (size_t)m * DM) : (A.in[I_XS] + (size_t)(m - TOK_P) * DM);
        const f32x4* x4 = (const f32x4*)xr + lane; u32x2* o = (u32x2*)(xb + (size_t)m * DM) + lane;
#pragma unroll
        for (int j = 0; j < 4; ++j) { const f32x4 v = x4[64 * j]; u32x2 w; w.x = pk2(v.x, v.y); w.y = pk2(v.z, v.w); o[64 * j] = w; }
    }
}

__device__ __forceinline__ s16x4 tr_read(unsigned lds_addr) { s16x4 r; asm volatile("ds_read_b64_tr_b16 %0, %1\n\ts_waitcnt lgkmcnt(0)" : "=&v"(r) : "v"(lds_addr) : "memory"); return r; }

__device__ __forceinline__ void attn_pass(const bf16_t* proj, const LAS float* bl, LAS unsigned char* vl, int tok0, int seqbase, int r, int r0, int h, int qt, int lane, unsigned (&ob)[16], float& ssout) {
    const int rr = lane & 31, hh = lane >> 5;
    bf16x8 qf[4];
#pragma unroll
    for (int ks = 0; ks < 4; ++ks) qf[ks] = *(const bf16x8*)(proj + (size_t)(tok0 + 32 * qt + rr) * NPROJ + 64 * h + 16 * ks + 8 * hh);
    f32x16 o[2];
#pragma unroll
    for (int a = 0; a < 2; ++a)
#pragma unroll
        for (int i = 0; i < 16; ++i) o[a][i] = 0.f;
    float m_run = -1e30f, l_run = 0.f;
    const float LOG2E = 1.4426950408889634f;
    const unsigned vbase = (unsigned)(size_t)vl;
    const int i16 = lane & 15, tq = i16 >> 2, tp = i16 & 3, blk = (lane >> 4) & 1;
    const int qc = 32 * qt + rr, cs = min(max(qc - 8, 0), 48);
#pragma unroll 1
    for (int kr = 0; kr < 8; ++kr) {
        const int ktok0 = seqbase + 64 * (r0 + kr);
#pragma unroll
        for (int i = 0; i < 8; ++i) { const int key = (lane >> 3) + 8 * i; const u32x4 v = *(const u32x4*)(proj + (size_t)(ktok0 + key) * NPROJ + 1024 + 64 * h + 8 * (lane & 7));
            *(LAS u32x4*)(vl + key * 144 + 16 * (lane & 7)) = v; }
        f32x16 s[2];
#pragma unroll
        for (int a = 0; a < 2; ++a)
#pragma unroll
            for (int i = 0; i < 16; ++i) s[a][i] = 0.f;
#pragma unroll
        for (int kt = 0; kt < 2; ++kt)
#pragma unroll
            for (int ks = 0; ks < 4; ++ks) { const bf16x8 kf = *(const bf16x8*)(proj + (size_t)(ktok0 + 32 * kt + rr) * NPROJ + 512 + 64 * h + 16 * ks + 8 * hh);
                s[kt] = MFMA32(kf, qf[ks], s[kt]); }
        const int dr = r0 + kr - r + 7; const LAS float* brow = bl + dr * 31 + 15;
        float mx = -1e30f;
#pragma unroll
        for (int kt = 0; kt < 2; ++kt)
#pragma unroll
            for (int i = 0; i < 16; ++i) { const int kc = 32 * kt + crow(i, hh); const bool valid = (kc >= cs) && (kc < cs + 16);
                const int bi = min(max(kc - qc, -15), 15);
                const float v = valid ? (s[kt][i] * 0.125f + brow[bi]) * LOG2E : -INFINITY; s[kt][i] = v; mx = fmaxf(mx, v); }
        mx = fmaxf(mx, __shfl_xor(mx, 32));
        const float mnew = fmaxf(m_run, mx), alpha = __builtin_amdgcn_exp2f(m_run - mnew);
        float sum = 0.f;
#pragma unroll
        for (int kt = 0; kt < 2; ++kt)
#pragma unroll
            for (int i = 0; i < 16; ++i) { const float p = __builtin_amdgcn_exp2f(s[kt][i] - mnew); s[kt][i] = p; sum += p; }
        sum += __shfl_xor(sum, 32);
        l_run = l_run * alpha + sum; m_run = mnew;
#pragma unroll
        for (int dt = 0; dt < 2; ++dt)
#pragma unroll
            for (int i = 0; i < 16; ++i) o[dt][i] *= alpha;
        LDS_WAIT();
#pragma unroll
        for (int kt = 0; kt < 2; ++kt)
#pragma unroll
            for (int st = 0; st < 2; ++st) {
                u32x4 w;
                w.x = pk2(s[kt][8 * st + 0], s[kt][8 * st + 1]); w.y = pk2(s[kt][8 * st + 2], s[kt][8 * st + 3]);
                w.z = pk2(s[kt][8 * st + 4], s[kt][8 * st + 5]); w.w = pk2(s[kt][8 * st + 6], s[kt][8 * st + 7]);
                const bf16x8 pf = __builtin_bit_cast(bf16x8, w);
#pragma unroll
                for (int dt = 0; dt < 2; ++dt) {
                    const unsigned a0 = vbase + (unsigned)((32 * kt + 16 * st + 4 * hh + tq) * 144 + 64 * dt + 32 * blk + 8 * tp);
                    const s16x4 lo = tr_read(a0), hi = tr_read(a0 + 8 * 144);
                    const bf16x8 vf = __builtin_shufflevector(lo, hi, 0, 1, 2, 3, 4, 5, 6, 7);
                    o[dt] = MFMA32(vf, pf, o[dt]);
                }
            }
    }
    const float inv = 1.0f / l_run; float ss = 0.f;
#pragma unroll
    for (int dt = 0; dt < 2; ++dt)
#pragma unroll
        for (int g = 0; g < 4; ++g) { const float v0 = o[dt][4 * g] * inv, v1 = o[dt][4 * g + 1] * inv, v2 = o[dt][4 * g + 2] * inv, v3 = o[dt][4 * g + 3] * inv;
            ss += (v0 * v0 + v1 * v1) + (v2 * v2 + v3 * v3); ob[dt * 8 + 2 * g] = pk2(v0, v1); ob[dt * 8 + 2 * g + 1] = pk2(v2, v3); }
    ss += __shfl_xor(ss, 32);
    ssout = ss;
}

__device__ __forceinline__ void attn_unit(const bf16_t* proj, const float* rpb, const float* g_attn, bf16_t* merged, LAS unsigned char* lds, int u, int wave, int lane) {
    const int tok0 = 64 * u; int rows, r, seqbase;
    if (u < 512) { rows = 32; r = u & 31; seqbase = (u >> 5) * 2048; } else { const int v = u - 512; rows = 64; r = v & 63; seqbase = TOK_P + (v >> 6) * 4096; }
    const int r0 = min(max(r - 4, 0), rows - 8);
    const int h = wave, rr = lane & 31, hh = lane >> 5;
    LAS unsigned char* vl = lds + wave * 9216;
    LAS float* bl = (LAS float*)(lds + 73728 + wave * 1920);
    LAS float* ssq = (LAS float*)(lds + 73728 + 8 * 1920);
    for (int i = lane; i < 465; i += 64) bl[i] = rpb[h * 465 + i];
    LDS_WAIT();
    unsigned ob0[16], ob1[16]; float ss0, ss1;
    attn_pass(proj, bl, vl, tok0, seqbase, r, r0, h, 0, lane, ob0, ss0);
    attn_pass(proj, bl, vl, tok0, seqbase, r, r0, h, 1, lane, ob1, ss1);
    if (hh == 0) { ssq[wave * 64 + rr] = ss0; ssq[wave * 64 + 32 + rr] = ss1; }
    __syncthreads();
#pragma unroll
    for (int qt = 0; qt < 2; ++qt) { float tot = 0.f;
#pragma unroll
        for (int w = 0; w < 8; ++w) tot += ssq[w * 64 + 32 * qt + rr];
        const float rs = 1.0f / sqrtf(tot * (1.0f / 512.0f) + RMS_EPS_F);
#pragma unroll
        for (int dt = 0; dt < 2; ++dt)
#pragma unroll
            for (int g = 0; g < 4; ++g) { const int d = 32 * dt + 8 * g + 4 * hh; const f32x4 gv = *(const f32x4*)(g_attn + 64 * h + d);
                const unsigned p0 = qt ? ob1[dt * 8 + 2 * g] : ob0[dt * 8 + 2 * g], p1 = qt ? ob1[dt * 8 + 2 * g + 1] : ob0[dt * 8 + 2 * g + 1];
                u32x2 w; w.x = pk2(bflo(p0) * rs * gv.x, bfhi(p0) * rs * gv.y); w.y = pk2(bflo(p1) * rs * gv.z, bfhi(p1) * rs * gv.w);
                *(LAS u32x2*)(vl + (32 * qt + rr) * 144 + 2 * d) = w; } }
    LDS_WAIT();
#pragma unroll
    for (int i = 0; i < 8; ++i) { const int q = (lane >> 3) + 8 * i; const u32x4 v = *(const LAS u32x4*)(vl + q * 144 + 16 * (lane & 7));
        *(u32x4*)(merged + (size_t)(tok0 + q) * DM + 64 * h + 8 * (lane & 7)) = v; }
    __syncthreads();
}

__device__ __forceinline__ void hyprep_unit(const bf16_t* proj, const float* sw, const float* sb, bf16_t* vT, bf16_t* x0T, LAS unsigned char* lds, int u, int tid) {
    const int tok0 = 64 * u; int L, s_tile, seqbase;
    if (u < 512) { L = 2048; s_tile = (u & 31) * 64; seqbase = (u >> 5) * 2048; } else { const int v = u - 512; L = 4096; s_tile = (v & 63) * 64; seqbase = TOK_P + (v >> 6) * 4096; }
    LAS unsigned* VL = (LAS unsigned*)lds;
    LAS unsigned* XL = VL + 512 * 33;
    const int half = tid >> 8, cp = tid & 255, c = 2 * cp;
    float w[3][3][2], bb[3][2];
#pragma unroll
    for (int st = 0; st < 3; ++st) {
#pragma unroll
        for (int k = 0; k < 3; ++k) { const f32x2 t = *(const f32x2*)(sw + k * 1536 + st * 512 + c); w[st][k][0] = t.x; w[st][k][1] = t.y; }
        const f32x2 t = *(const f32x2*)(sb + st * 512 + c); bb[st][0] = t.x; bb[st][1] = t.y; }
    const int sbeg = s_tile + 32 * half;
    const bf16_t* pbase = proj + (size_t)(tok0 + 32 * half) * NPROJ + 1536 + c;
    float prev[3][2], cur[3][2], nxt[3][2];
#pragma unroll
    for (int st = 0; st < 3; ++st) {
        unsigned a = 0u; if (sbeg - 1 >= 0) a = *(const unsigned*)(pbase - NPROJ + st * 512);
        const unsigned b = *(const unsigned*)(pbase + st * 512);
        prev[st][0] = bflo(a); prev[st][1] = bfhi(a); cur[st][0] = bflo(b); cur[st][1] = bfhi(b); }
    float vprev[2] = {0.f, 0.f}, xprev[2] = {0.f, 0.f};
#pragma unroll 4
    for (int i = 0; i < 32; ++i) {
        float uc[3][2];
#pragma unroll
        for (int st = 0; st < 3; ++st) {
            unsigned a = 0u; if (sbeg + i + 1 < L) a = *(const unsigned*)(pbase + (size_t)(i + 1) * NPROJ + st * 512);
            nxt[st][0] = bflo(a); nxt[st][1] = bfhi(a);
#pragma unroll
            for (int e = 0; e < 2; ++e) { uc[st][e] = w[st][0][e] * prev[st][e] + w[st][1][e] * cur[st][e] + w[st][2][e] * nxt[st][e] + bb[st][e]; prev[st][e] = cur[st][e]; cur[st][e] = nxt[st][e]; }
        }
        const float v0 = uc[2][0] * uc[1][0], v1 = uc[2][1] * uc[1][1];
        if (i & 1) { const int tp = (32 * half + i) >> 1;
            VL[c * 33 + tp] = pk2(vprev[0], v0); VL[(c + 1) * 33 + tp] = pk2(vprev[1], v1);
            XL[c * 33 + tp] = pk2(xprev[0], uc[0][0]); XL[(c + 1) * 33 + tp] = pk2(xprev[1], uc[0][1]); }
        vprev[0] = v0; vprev[1] = v1; xprev[0] = uc[0][0]; xprev[1] = uc[0][1];
    }
    __syncthreads();
    const size_t obase = (size_t)512 * seqbase + s_tile;
    for (int it = tid; it < 2 * 512 * 8; it += 512) { const int arr = it >> 12, row = (it >> 3) & 511, ch = it & 7;
        const LAS unsigned* src = (arr ? XL : VL) + row * 33 + 4 * ch; u32x4 v; v.x = src[0]; v.y = src[1]; v.z = src[2]; v.w = src[3];
        *(u32x4*)((arr ? x0T : vT) + obase + (size_t)row * L + 8 * ch) = v; }
    __syncthreads();
}

template <int L, int B>
__device__ __forceinline__ void toeplitz_unit(const bf16_t* Rg, const bf16_t* vT, bf16_t* hyT, const bf16_t* x0T, const float* fbias, LAS unsigned char* lds, int c, size_t kind_base, int tid, int wave, int lane) {
    constexpr int NB = L / 64, T1PT = 32 / B, PAD = T1PT - 1, NTILES = NB / T1PT, NTW = NTILES / 8;
    constexpr int VROWS = (NB + 2 * PAD) * B, VBYTES = VROWS * 144;
    LAS unsigned char* Vl = lds;
    LAS unsigned* E = (LAS unsigned*)(lds + VBYTES);
    LAS unsigned* O = E + L + 16;
    const bf16_t* vch = vT + kind_base + (size_t)c * L;
    bf16_t* hch = hyT + kind_base + (size_t)c * L;
    const bf16_t* xch = x0T + kind_base + (size_t)c * L;
    for (int idx = tid; idx < NB * B * 8; idx += 512) { const int ch = idx & 7, row = idx >> 3, b = row % B, s1 = row / B;
        const u32x4 v = *(const u32x4*)(vch + (size_t)b * 512 * L + 64 * s1 + 8 * ch);
        *(LAS u32x4*)(Vl + ((s1 + PAD) * B + b) * 144 + 16 * ch) = v; }
    for (int idx = tid; idx < 2 * PAD * B * 9; idx += 512) { const int ch = idx % 9, row = idx / 9; const int rrow = row < PAD * B ? row : (NB * B + row);
        *(LAS u32x4*)(Vl + rrow * 144 + 16 * ch) = (u32x4){0u, 0u, 0u, 0u}; }
    { const u32x4* src = (const u32x4*)(Rg + (size_t)c * 4 * L);
      for (int idx = tid; idx < L / 2; idx += 512) { const int cp = idx / (L / 4), k = idx % (L / 4); const u32x4 v = src[idx]; *(LAS u32x4*)((cp ? O : E) + 4 * k) = v; } }
    __syncthreads();
    const int rr = lane & 31, hh = lane >> 5;
    const LAS unsigned* fb = ((rr & 1) ? O : E) + ((L + 8 * hh - rr - (rr & 1)) >> 1);
    f32x16 acc[NTW][2];
#pragma unroll
    for (int i = 0; i < NTW; ++i)
#pragma unroll
        for (int m = 0; m < 2; ++m)
#pragma unroll
            for (int k = 0; k < 16; ++k) acc[i][m][k] = 0.f;
    const int t1l = rr / B, bcol = rr % B;
    const int dlo = T1PT * wave - (NB - 1), dhi = T1PT * (wave + 8 * (NTW - 1)) + T1PT - 1;
    for (int d = dlo; d <= dhi; ++d) {
        bf16x8 F[6];
#pragma unroll
        for (int q = 0; q < 6; ++q) { const LAS unsigned* p = fb - 8 * (4 * d - 3 + q); u32x4 w; w.x = p[0]; w.y = p[1]; w.z = p[2]; w.w = p[3]; F[q] = __builtin_bit_cast(bf16x8, w); }
#pragma unroll
        for (int i = 0; i < NTW; ++i) { const int j = wave + 8 * i;
            if (d >= T1PT * j - (NB - 1) && d <= T1PT * j + T1PT - 1) {
                const LAS unsigned char* vb = Vl + ((T1PT * j + t1l - d + PAD) * B + bcol) * 144 + 16 * hh;
#pragma unroll
                for (int kt = 0; kt < 4; ++kt) { const bf16x8 bf = *(const LAS bf16x8*)(vb + 32 * kt);
#pragma unroll
                    for (int mt = 0; mt < 2; ++mt) acc[i][mt] = MFMA32(F[2 * mt - kt + 3], bf, acc[i][mt]); }
            } }
    }
    const float fbv = fbias[c];
#pragma unroll
    for (int i = 0; i < NTW; ++i) { const int j = wave + 8 * i, t1 = T1PT * j + t1l;
#pragma unroll
        for (int mt = 0; mt < 2; ++mt)
#pragma unroll
            for (int g = 0; g < 4; ++g) { const int t0 = 32 * mt + 8 * g + 4 * hh;
                const u32x2 vv = *(const LAS u32x2*)(Vl + ((t1 + PAD) * B + bcol) * 144 + 2 * t0);
                const size_t go = (size_t)bcol * 512 * L + 64 * t1 + t0;
                const u32x2 xv = *(const u32x2*)(xch + go);
                const float y0 = (acc[i][mt][4 * g + 0] + fbv * bflo(vv.x)) * bflo(xv.x), y1 = (acc[i][mt][4 * g + 1] + fbv * bfhi(vv.x)) * bfhi(xv.x);
                const float y2 = (acc[i][mt][4 * g + 2] + fbv * bflo(vv.y)) * bflo(xv.y), y3 = (acc[i][mt][4 * g + 3] + fbv * bfhi(vv.y)) * bfhi(xv.y);
                u32x2 w; w.x = pk2(y0, y1); w.y = pk2(y2, y3);
                *(u32x2*)(hch + go) = w; } }
    __syncthreads();
}

__device__ __forceinline__ void hynorm_unit(const bf16_t* hyT, const float* g_hy, bf16_t* merged, LAS unsigned char* lds, int u, int tid, int wave, int lane) {
    const int tok0 = 64 * u; int L, s_tile, seqbase;
    if (u < 512) { L = 2048; s_tile = (u & 31) * 64; seqbase = (u >> 5) * 2048; } else { const int v = u - 512; L = 4096; s_tile = (v & 63) * 64; seqbase = TOK_P + (v >> 6) * 4096; }
    LAS unsigned char* HL = lds;
    LAS float* ssq = (LAS float*)(lds + 512 * 144);
    const size_t ibase = (size_t)512 * seqbase + s_tile;
    for (int it = tid; it < 512 * 8; it += 512) { const int row = it >> 3, ch = it & 7;
        *(LAS u32x4*)(HL + row * 144 + 16 * ch) = *(const u32x4*)(hyT + ibase + (size_t)row * L + 8 * ch); }
    __syncthreads();
    float ss = 0.f;
    const LAS unsigned short* col = (const LAS unsigned short*)(HL + (64 * wave) * 144) + lane;
#pragma unroll 8
    for (int k = 0; k < 64; ++k) { const float v = bf2f(col[k * 72]); ss += v * v; }
    ssq[wave * 64 + lane] = ss;
    __syncthreads();
    float tot = 0.f;
#pragma unroll
    for (int w = 0; w < 8; ++w) tot += ssq[w * 64 + lane];
    const float rs = 1.0f / sqrtf(tot * (1.0f / 512.0f) + RMS_EPS_F);
    bf16_t* orow = merged + (size_t)(tok0 + lane) * DM + 512 + 64 * wave;
#pragma unroll
    for (int k8 = 0; k8 < 8; ++k8) { float v[8];
#pragma unroll
        for (int e = 0; e < 8; ++e) v[e] = bf2f(col[(8 * k8 + e) * 72]) * rs * g_hy[64 * wave + 8 * k8 + e];
        u32x4 w; w.x = pk2(v[0], v[1]); w.y = pk2(v[2], v[3]); w.z = pk2(v[4], v[5]); w.w = pk2(v[6], v[7]);
        *(u32x4*)(orow + 8 * k8) = w; }
    __syncthreads();
}

__device__ __forceinline__ void ln_rows(float* io, bf16_t* ob, const float* g, const float* b, int gw, int NGW, int lane) {
    f32x4 gv[4], bv[4];
#pragma unroll
    for (int j = 0; j < 4; ++j) { gv[j] = ((const f32x4*)g)[lane + 64 * j]; bv[j] = ((const f32x4*)b)[lane + 64 * j]; }
    for (int m = gw; m < T_TOK; m += NGW) {
        f32x4* xr = (f32x4*)(io + (size_t)m * DM) + lane;
        f32x4 v[4]; float s = 0.f;
#pragma unroll
        for (int j = 0; j < 4; ++j) { v[j] = xr[64 * j]; s += (v[j].x + v[j].y) + (v[j].z + v[j].w); }
        const float mean = wave_sum(s) * (1.f / DM); float s2 = 0.f;
#pragma unroll
        for (int j = 0; j < 4; ++j) { v[j] = v[j] - mean; s2 += (v[j].x * v[j].x + v[j].y * v[j].y) + (v[j].z * v[j].z + v[j].w * v[j].w); }
        const float rstd = 1.f / sqrtf(wave_sum(s2) * (1.f / DM) + LN_EPS_F);
#pragma unroll
        for (int j = 0; j < 4; ++j) { const f32x4 y = v[j] * rstd * gv[j] + bv[j]; xr[64 * j] = y;
            if (ob) { u32x2 w; w.x = pk2(y.x, y.y); w.y = pk2(y.z, y.w); ((u32x2*)(ob + (size_t)m * DM))[lane + 64 * j] = w; } }
    }
}

__device__ __forceinline__ void convgelu_chunk(const bf16_t* U, bf16_t* H, const float* cw, const float* cb, int L, int gtid, int nthreads) {
    constexpr int NG = DFF / 4, RUN = 16;
    const int nitems = (CHUNK / RUN) * NG;
    for (int it = gtid; it < nitems; it += nthreads) {
        const int g = it % NG, run = it / NG, c = 4 * g, t0 = run * RUN, s0 = t0 % L;
        f32x4 wa[3], wg[3];
#pragma unroll
        for (int k = 0; k < 3; ++k) { wa[k] = *(const f32x4*)(cw + k * NFF + c); wg[k] = *(const f32x4*)(cw + k * NFF + DFF + c); }
        const f32x4 ba = *(const f32x4*)(cb + c), bg = *(const f32x4*)(cb + DFF + c);
        const bf16_t* ua = U + (size_t)t0 * NFF + c; const bf16_t* ug = ua + DFF;
        f32x4 pa, pg, ca, cg_, na, ng;
        { u32x2 a = {0u, 0u}, b = {0u, 0u}; if (s0 > 0) { a = *(const u32x2*)(ua - NFF); b = *(const u32x2*)(ug - NFF); }
          pa = (f32x4){bflo(a.x), bfhi(a.x), bflo(a.y), bfhi(a.y)}; pg = (f32x4){bflo(b.x), bfhi(b.x), bflo(b.y), bfhi(b.y)};
          a = *(const u32x2*)(ua); b = *(const u32x2*)(ug);
          ca = (f32x4){bflo(a.x), bfhi(a.x), bflo(a.y), bfhi(a.y)}; cg_ = (f32x4){bflo(b.x), bfhi(b.x), bflo(b.y), bfhi(b.y)}; }
#pragma unroll 4
        for (int i = 0; i < RUN; ++i) {
            u32x2 a = {0u, 0u}, b = {0u, 0u}; if (s0 + i + 1 < L) { a = *(const u32x2*)(ua + (size_t)(i + 1) * NFF); b = *(const u32x2*)(ug + (size_t)(i + 1) * NFF); }
            na = (f32x4){bflo(a.x), bfhi(a.x), bflo(a.y), bfhi(a.y)}; ng = (f32x4){bflo(b.x), bfhi(b.x), bflo(b.y), bfhi(b.y)};
            const f32x4 va = wa[0] * pa + wa[1] * ca + wa[2] * na + ba, vg = wg[0] * pg + wg[1] * cg_ + wg[2] * ng + bg;
            const pg8::f32x2 g01 = pg8::gelu_pk((pg8::f32x2){vg[0], vg[1]}), g23 = pg8::gelu_pk((pg8::f32x2){vg[2], vg[3]});
            const f32x4 hv = va * (f32x4){g01.x, g01.y, g23.x, g23.y};
            u32x2 w; w.x = pk2(hv[0], hv[1]); w.y = pk2(hv[2], hv[3]);
            *(u32x2*)(H + (size_t)(t0 + i) * DFF + c) = w;
            pa = ca; pg = cg_; ca = na; cg_ = ng;
        }
    }
}

constexpr int NPHASE = 15;
__global__ void __launch_bounds__(512) fwd_kernel(Args A) {
    extern __shared__ __attribute__((aligned(16))) unsigned char lds_raw[];
    LAS unsigned char* lds = (LAS unsigned char*)lds_raw;
    cg::grid_group grid = cg::this_grid();
    const int tid = threadIdx.x, lane = tid & 63, wave = __builtin_amdgcn_readfirstlane(tid >> 6);
    const int bx = blockIdx.x, G = gridDim.x;
    unsigned char* ws = A.ws;
    bf16_t* xb = (bf16_t*)(ws + WS_XB); bf16_t* merged = xb;
    bf16_t* proj = (bf16_t*)(ws + WS_PROJ);
    bf16_t* vT = (bf16_t*)A.out; bf16_t* x0T = vT + (size_t)T_TOK * HYW; bf16_t* hyT = x0T + (size_t)T_TOK * HYW;
    bf16_t* x1b = (bf16_t*)(ws + WS_X1B); bf16_t* ubuf = (bf16_t*)(ws + WS_U); bf16_t* hbuf = (bf16_t*)(ws + WS_HID);
    const int lo = A.ph_lo, hi = A.ph_hi;
    volatile LAS unsigned* bst = (volatile LAS unsigned*)(lds + LDS_BYTES - 64);
    if (tid < 16) bst[tid] = 0u;
    __syncthreads();
    XcdBarrier xbar = xcd_barrier_post((unsigned*)ws + A.li * XCD_BAR_WORDS, bst);
#ifndef PHASE_MASK
#define PHASE_MASK 0x7fff
#endif
#define IN(k) (((PHASE_MASK >> (k)) & 1) && lo <= (k) && (k) < hi)
#ifndef DUP_PHASE
#define DUP_PHASE -1
#endif
#define REPS(k)
#ifndef CG_SEAMS
#define CG_SEAMS 1
#endif
#define SEAM(k) do { if (IN(k) && IN((k) + 1)) { if ((k) < CG_SEAMS) grid.sync(); else xcd_barrier(xbar); } } while (0)
#ifdef EXTRA_SYNCS
    for (int i_ = 0; i_ < EXTRA_SYNCS; ++i_) grid.sync();
#endif
    if (IN(0)) REPS(0) { p0_prologue(A, lds, tid, wave, lane); }
    SEAM(0);
    if (IN(1)) REPS(1) { pg8::Gemm g{xb, (const bf16_t*)(ws + WS_WIN), T_TOK, NPROJ, DM}; pg8::StaticOrder S; S.init(T_TOK, NPROJ, G, bx);
        pg8::EpiBf16<0> E{proj, NPROJ, nullptr, 0, 0, 1.f};
        pg8::gemm_phase<pg8::EpiBf16<0>, pg8::StaticOrder, true, true>(lds, g, S, E); }
    SEAM(1);
    if (IN(2)) {
#ifndef ATT_REPS
#define ATT_REPS 1
#endif
        for (int rep_ = 0; rep_ < ATT_REPS; ++rep_) for (int u = bx; u < 768; u += G) attn_unit(proj, A.in[I_RPB], A.in[I_GA], merged, lds, u, wave, lane);
        REPS(20) for (int u = bx; u < 768; u += G) hyprep_unit(proj, A.in[I_SW], A.in[I_SB], vT, x0T, lds, u, tid);
    }
    SEAM(2);
    if (IN(3)) {
        REPS(3) for (int u = bx; u < 1024; u += G) {
            if (u < 512) toeplitz_unit<L_P, 16>((const bf16_t*)(ws + WS_FILT_P), vT, hyT, x0T, A.in[I_FBIAS], lds, u, 0, tid, wave, lane);
            else toeplitz_unit<L_S, 4>((const bf16_t*)(ws + WS_FILT_S), vT, hyT, x0T, A.in[I_FBIAS], lds, u - 512, (size_t)512 * TOK_P, tid, wave, lane);
        }
    }
    SEAM(3);
    if (IN(4)) REPS(4) { for (int u = bx; u < 768; u += G) hynorm_unit(hyT, A.in[I_GH], merged, lds, u, tid, wave, lane); }
    SEAM(4);
    if (IN(5)) REPS(5) {
        { pg8::Gemm g{merged, (const bf16_t*)(ws + WS_WOUT), TOK_P, DM, DM}; pg8::StaticOrder S; S.init(TOK_P, DM, G, bx);
          pg8::EpiAxpyF32 E{A.in[I_XP], A.out, DM, ALPHA_F};
          pg8::gemm_phase<pg8::EpiAxpyF32, pg8::StaticOrder, true, true>(lds, g, S, E); }
        { pg8::Gemm g{merged + (size_t)TOK_P * DM, (const bf16_t*)(ws + WS_WOUT), T_TOK - TOK_P, DM, DM}; pg8::StaticOrder S; S.init(T_TOK - TOK_P, DM, G, bx);
          pg8::EpiAxpyF32 E{A.in[I_XS], A.out + (size_t)TOK_P * DM, DM, ALPHA_F};
          pg8::gemm_phase<pg8::EpiAxpyF32, pg8::StaticOrder, true, true>(lds, g, S, E); }
    }
    SEAM(5);
    if (IN(6)) ln_rows(A.out, x1b, A.in[I_LN1G], A.in[I_LN1B], bx * 8 + wave, G * 8, lane);
    SEAM(6);
#pragma unroll
    for (int k = 0; k < NCHUNK + 1; ++k) {
        const int ph = 7 + 2 * k;
        if (IN(ph)) {
            if (k >= 1) { pg8::Gemm g{hbuf, (const bf16_t*)(ws + WS_WF2), CHUNK, DM, DFF}; pg8::StaticOrder S; S.init(CHUNK, DM, G, bx);
                float* o = A.out + (size_t)(k - 1) * CHUNK * DM; pg8::EpiAxpyF32 E{o, o, DM, ALPHA_F};
                pg8::gemm_phase<pg8::EpiAxpyF32, pg8::StaticOrder, true, true>(lds, g, S, E); }
            if (k < NCHUNK) REPS(7 + 100 * k) { pg8::Gemm g{x1b + (size_t)k * CHUNK * DM, (const bf16_t*)(ws + WS_WF1), CHUNK, NFF, DM}; pg8::StaticOrder S; S.init(CHUNK, NFF, G, bx);
                pg8::EpiBf16<0> E{ubuf, NFF, nullptr, 0, 0, 1.f};
                pg8::gemm_phase<pg8::EpiBf16<0>, pg8::StaticOrder, true, true>(lds, g, S, E); }
        }
        SEAM(ph);
        if (k < NCHUNK) {
            if (IN(ph + 1)) REPS(8 + 100 * k) convgelu_chunk(ubuf, hbuf, A.in[I_FFCW], A.in[I_FFCB], k < 2 ? L_P : L_S, bx * 512 + tid, G * 512);
            SEAM(ph + 1);
        }
    }
    if (IN(14)) ln_rows(A.out, nullptr, A.in[I_LN2G], A.in[I_LN2B], bx * 8 + wave, G * 8, lane);
#undef IN
#undef SEAM
}

#ifndef MK_PER_PHASE
#define MK_PER_PHASE 0
#endif
extern "C" void kernel_launch(void* const* d_in, const int* in_sizes, int n_in, void* d_out, int out_size, void* d_ws, size_t ws_size, hipStream_t stream) {
    static int grid = 0;
    if (grid == 0) {
        if (n_in != 24 || out_size != T_TOK * DM || ws_size < WS_NEED) { fprintf(stderr, "kernel_launch: unexpected shapes n_in %d out %d ws %zu\n", n_in, out_size, ws_size); grid = -1; return; }
        int dev = 0, cus = 0, per_cu = 0;
        hipGetDevice(&dev); hipDeviceGetAttribute(&cus, hipDeviceAttributeMultiprocessorCount, dev);
        if (hipFuncSetAttribute((const void*)fwd_kernel, hipFuncAttributeMaxDynamicSharedMemorySize, LDS_BYTES) != hipSuccess) { fprintf(stderr, "hipFuncSetAttribute failed\n"); grid = -1; return; }
        if (hipOccupancyMaxActiveBlocksPerMultiprocessor(&per_cu, (const void*)fwd_kernel, 512, LDS_BYTES) != hipSuccess || per_cu < 1) { fprintf(stderr, "occupancy query: %d\n", per_cu); per_cu = 1; }
        (void)hipGetLastError();
        grid = cus * 1;
        fprintf(stderr, "kernel_launch: grid %d (cus %d, per_cu %d) ws %zu\n", grid, cus, per_cu, ws_size);
    }
    if (grid < 0) return;
    Args a{};
    for (int i = 0; i < 24; ++i) a.in[i] = (const float*)d_in[i];
    a.out = (float*)d_out; a.ws = (unsigned char*)d_ws;
#if MK_PER_PHASE
    for (int p = 0; p < NPHASE; ++p) { a.ph_lo = p; a.ph_hi = p + 1; hipLaunchKernelGGL(fwd_kernel, dim3(grid), dim3(512), LDS_BYTES, stream, a); }
#else
    void* args[] = {&a};
    (void)hipMemsetAsync(d_ws, 0, 65536, stream);
#if DUP_PHASE >= 0
    a.ph_lo = 0; a.ph_hi = DUP_PHASE + 1; a.li = 1;
    (void)hipLaunchCooperativeKernel((const void*)fwd_kernel, dim3(grid), dim3(512), args, LDS_BYTES, stream);
    a.ph_lo = DUP_PHASE; a.ph_hi = NPHASE; a.li = 0;
#else
    a.ph_lo = 0; a.ph_hi = NPHASE;
#endif
    hipError_t e = hipLaunchCooperativeKernel((const void*)fwd_kernel, dim3(grid), dim3(512), args, LDS_BYTES, stream);
    if (e != hipSuccess) fprintf(stderr, "cooperative launch failed: %s (grid %d)\n", hipGetErrorString(e), grid);
#endif
}
```

```cpp
#include <hip/hip_runtime.h>
#include <hip/hip_cooperative_groups.h>
#include <cstdio>
#include <cstdint>
namespace cg = cooperative_groups;
namespace pg8 {
#define PG8_LAS __attribute__((address_space(3)))
typedef unsigned short bf16_t;
typedef short bf16x8 __attribute__((ext_vector_type(8)));
typedef float f32x4 __attribute__((ext_vector_type(4)));
typedef unsigned u32x4 __attribute__((ext_vector_type(4)));
constexpr int BM = 256, BK = 64, HALF = 128, HTB = HALF * BK * 2  , STAGE_BYTES = 8 * HTB, NXCD = 8, WGM = 8;

__host__ __device__ __forceinline__ int lds_byte(int r, int c) { const int st = (r >> 4) * 2 + (c >> 5), rr = r & 15, cc = c & 31, ob = rr * 64 + cc * 2; return st * 1024 + (ob ^ (((ob >> 9) & 1) << 5)); }
__host__ __device__ __forceinline__ void stage_rc(int b, int& R, int& C) { const int st = b / 1024, sb = b % 1024, swz = sb ^ (((sb >> 9) & 1) << 5); R = (st >> 1) * 16 + swz / 64; C = (st & 1) * 32 + (swz % 64) / 2; }
__host__ __device__ __forceinline__ int perm32(int rho) { const int n = rho >> 4, i = rho & 15; return 8 * (i >> 2) + 4 * n + (i & 3); }

struct Unit { int pm, pn; };
struct Gemm { const bf16_t* A; const bf16_t* Bt; int M, N, K; };

struct StaticOrder {
    int nM, nN, nwg, G, c;
    __host__ __device__ void init(int M, int N, int G_, int c_) { nM = M / BM; nN = N / BM; nwg = nM * nN; G = G_; c = c_; }
    __host__ __device__ bool next(int i, Unit& u) const {
        const long L = (long)i * G + c; if (L >= nwg) return false;
        int wgid = (int)L; { const int q = nwg / NXCD, r = nwg % NXCD, xcd = wgid % NXCD, off = wgid / NXCD; wgid = (xcd < r ? xcd * (q + 1) : r * (q + 1) + (xcd - r) * q) + off; }
        const int nig = WGM * nN, gid = wgid / nig, fm = gid * WGM, gsz = (nM - fm) < WGM ? (nM - fm) : WGM;
        u.pm = fm + ((wgid % nig) % gsz); u.pn = (wgid % nig) / gsz; return true;
    }
    __device__ __forceinline__ void a_ready(const Unit&) const {}
    __device__ __forceinline__ void done(const Unit&) const {}
};

__device__ __forceinline__ unsigned cvt_pk_bf16(float lo, float hi) { unsigned r; asm volatile("v_cvt_pk_bf16_f32 %0, %1, %2" : "=v"(r) : "v"(lo), "v"(hi)); return r; }
typedef float f32x2 __attribute__((ext_vector_type(2)));
__device__ __forceinline__ f32x2 gelu_pk(f32x2 v) {
    const f32x2 av = __builtin_elementwise_abs(v), d = av * 0.2316418882f + 1.0f;
    f32x2 t; t.x = __builtin_amdgcn_rcpf(d.x); t.y = __builtin_amdgcn_rcpf(d.y);
    f32x2 q = t * 0.5307027145f + (-0.7265760135f); q = q * t + 0.7107068705f; q = q * t + (-0.142248368f); q = q * t + 0.127414796f; q = q * t;
    const f32x2 s = (v * v) * (-0.72134752044f);
    f32x2 e; e.x = __builtin_amdgcn_exp2f(s.x); e.y = __builtin_amdgcn_exp2f(s.y);
    const f32x2 m = v * (q * e), r = v - m;
    f32x2 o; o.x = v.x < 0.f ? m.x : r.x; o.y = v.y < 0.f ? m.y : r.y; return o;
}

template <int ACT  > struct EpiBf16 {
    static constexpr bool PERM = true, AFTER_DRAIN = false; static_assert(ACT == 0 || ACT == 1, "EpiBf16: ACT is 0 (none) or 1 (gelu_pk)");
    bf16_t* O; int ldc; const float* bias; int split_cols; size_t split_stride; float scale0;
    __device__ __forceinline__ void operator()(const f32x4 (&acc)[2][2][4][2], const Unit& u, int wr, int wc, int fr, int fq) const {
        const int row0 = u.pm * BM + wr * 64 + fr; int colt = u.pn * BM; bf16_t* base = O;
        float sc = 1.f; if (split_cols) { const int t = colt / split_cols; base += (size_t)t * split_stride; colt -= t * split_cols; if (t == 0) sc = scale0; }
        const int col0 = colt + wc * 32 + 8 * fq, bcol0 = u.pn * BM + wc * 32 + 8 * fq;
        f32x4 bv[2][2];
#pragma unroll
        for (int bj = 0; bj < 2; ++bj)
#pragma unroll
            for (int n = 0; n < 2; ++n) bv[bj][n] = bias ? *(const f32x4*)(bias + bcol0 + bj * HALF + 4 * n) : (f32x4){0.f, 0.f, 0.f, 0.f};
#pragma unroll
        for (int ai = 0; ai < 2; ++ai)
#pragma unroll
            for (int m = 0; m < 4; ++m) { bf16_t* rowp = base + (size_t)(row0 + ai * HALF + m * 16) * ldc + col0;
#pragma unroll
                for (int bj = 0; bj < 2; ++bj) { f32x4 v0 = acc[ai][bj][m][0] + bv[bj][0], v1 = acc[ai][bj][m][1] + bv[bj][1];
                    if (ACT == 1) { f32x2 a = gelu_pk((f32x2){v0[0], v0[1]}), b = gelu_pk((f32x2){v0[2], v0[3]}), c = gelu_pk((f32x2){v1[0], v1[1]}), d = gelu_pk((f32x2){v1[2], v1[3]});
                        v0 = (f32x4){a.x, a.y, b.x, b.y}; v1 = (f32x4){c.x, c.y, d.x, d.y}; }
                    v0 = v0 * sc; v1 = v1 * sc; u32x4 w; w.x = cvt_pk_bf16(v0[0], v0[1]); w.y = cvt_pk_bf16(v0[2], v0[3]); w.z = cvt_pk_bf16(v1[0], v1[1]); w.w = cvt_pk_bf16(v1[2], v1[3]);
                    *(u32x4*)(rowp + bj * HALF) = w; } }
    }
};
template <class Epi, class Sched, bool ALIGN_EPI = false, bool SP2 = false>
__device__ __forceinline__ void gemm_phase(PG8_LAS unsigned char* lds, const Gemm g, const Sched& S, const Epi& E) {
    const int tid = threadIdx.x, wid = __builtin_amdgcn_readfirstlane(tid >> 6), lane = tid & 63, wr = wid >> 2, wc = wid & 3, fr = lane & 15, fq = lane >> 4;
    const int K = g.K, nt = K / BK;
    unsigned voffA[2], voffB[2];
#pragma unroll
    for (int i = 0; i < 2; ++i) { int R, C; stage_rc(tid * 16 + i * 8192, R, C); const int Rb = Epi::PERM ? ((R & ~31) + perm32(R & 31)) : R;
        voffA[i] = (unsigned)(R * K + C) * 2u; voffB[i] = (unsigned)(Rb * K + C) * 2u; }
    const size_t kstep = (size_t)(BK * 2);
    const size_t hstep = (size_t)HALF * K * 2;
    const size_t tstep = 2 * hstep;
    const unsigned ldsw = (unsigned)wid * 1024u;
    const int aoff = lds_byte(wr * 64 + fr, fq * 8), boff = lds_byte(wc * 32 + fr, fq * 8);
#define PG8_SA(b, h) (((b) * 2 + (h)) * HTB)
#define PG8_SB(b, h) ((4 + (b) * 2 + (h)) * HTB)
#define PG8_STAGE(bufoff, gbase, voff) do { _Pragma("unroll") for (int _i = 0; _i < 2; ++_i) \
        __builtin_amdgcn_global_load_lds((const unsigned*)((const char*)(gbase) + (voff)[_i]), (PG8_LAS unsigned*)(lds + (bufoff) + ldsw + _i * 8192), 16, 0, 0); } while (0)
#define PG8_LDA(dst, b, h) do { _Pragma("unroll") for (int m = 0; m < 4; ++m) _Pragma("unroll") for (int k = 0; k < 2; ++k) dst[m][k] = *(const PG8_LAS bf16x8*)(lds + PG8_SA(b, h) + aoff + m * 2048 + k * 1024); } while (0)
#define PG8_LDB(dst, b, h) do { _Pragma("unroll") for (int n = 0; n < 2; ++n) _Pragma("unroll") for (int k = 0; k < 2; ++k) dst[n][k] = *(const PG8_LAS bf16x8*)(lds + PG8_SB(b, h) + boff + n * 2048 + k * 1024); } while (0)
#define PG8_MMA(ai, bj, At, Bt) do { __builtin_amdgcn_s_setprio(1); _Pragma("unroll") for (int m = 0; m < 4; ++m) _Pragma("unroll") for (int n = 0; n < 2; ++n) _Pragma("unroll") for (int k = 0; k < 2; ++k) \
        acc[ai][bj][m][n] = __builtin_amdgcn_mfma_f32_16x16x32_bf16(Bt[n][k], At[m][k], acc[ai][bj][m][n], 0, 0, 0); __builtin_amdgcn_s_setprio(0); } while (0)
#define PG8_WAIT_V(n) asm volatile("s_waitcnt vmcnt(" #n ")" ::: "memory")
#define PG8_WAIT_L(n) asm volatile("s_waitcnt lgkmcnt(" #n ")" ::: "memory")
#define PG8_BAR __builtin_amdgcn_s_barrier()
#define PG8_SCHED __builtin_amdgcn_sched_barrier(0)
    Unit cur, nxt; int ui = 0;
    if (!S.next(0, cur)) return;
    f32x4 acc[2][2][4][2];
#pragma unroll
    for (int a = 0; a < 2; ++a)
#pragma unroll
        for (int b = 0; b < 2; ++b)
#pragma unroll
            for (int m = 0; m < 4; ++m)
#pragma unroll
                for (int n = 0; n < 2; ++n) acc[a][b][m][n] = (f32x4){0.f, 0.f, 0.f, 0.f};
    bf16x8 At[4][2], B0[2][2], B1[2][2];
    const char* cA = (const char*)g.A + (size_t)cur.pm * tstep; const char* cB = (const char*)g.Bt + (size_t)cur.pn * tstep;
    S.a_ready(cur);
    if constexpr (SP2) {
        PG8_STAGE(PG8_SB(0, 0), cB, voffB); PG8_STAGE(PG8_SB(0, 1), cB + hstep, voffB); PG8_STAGE(PG8_SA(0, 0), cA, voffA); PG8_STAGE(PG8_SA(0, 1), cA + hstep, voffA);
        if (wr == 1) PG8_BAR;
        PG8_WAIT_V(2); PG8_BAR;
        PG8_STAGE(PG8_SB(1, 0), cB + kstep, voffB); PG8_STAGE(PG8_SA(1, 0), cA + kstep, voffA); PG8_STAGE(PG8_SB(1, 1), cB + hstep + kstep, voffB);
        PG8_WAIT_V(6); PG8_BAR;
    } else {
        PG8_STAGE(PG8_SB(0, 0), cB, voffB); PG8_STAGE(PG8_SA(0, 0), cA, voffA); PG8_STAGE(PG8_SB(0, 1), cB + hstep, voffB); PG8_STAGE(PG8_SA(0, 1), cA + hstep, voffA);
        if (wr == 1) PG8_BAR;
        PG8_WAIT_V(4); PG8_BAR;
        PG8_STAGE(PG8_SB(1, 0), cB + kstep, voffB); PG8_STAGE(PG8_SA(1, 0), cA + kstep, voffA); PG8_STAGE(PG8_SB(1, 1), cB + hstep + kstep, voffB);
        PG8_WAIT_V(6); PG8_BAR;
    }
    for (;;) {
        const bool has_next = S.next(ui + 1, nxt);
        const char* nA = has_next ? (const char*)g.A + (size_t)nxt.pm * tstep : cA; const char* nB = has_next ? (const char*)g.Bt + (size_t)nxt.pn * tstep : cB;
        for (int t = 0; t < nt; t += 2) {
            const bool last = (t == nt - 2);
            const char* a1 = cA + (size_t)(t + 1) * kstep;
            const char* a2 = last ? nA : cA + (size_t)(t + 2) * kstep; const char* b2 = last ? nB : cB + (size_t)(t + 2) * kstep;
            const char* a3 = a2 + kstep; const char* b3 = b2 + kstep;
            if (last && has_next) S.a_ready(nxt);
            if constexpr (SP2) {
            PG8_LDB(B0, 0, 0); PG8_LDB(B1, 0, 1); PG8_SCHED; PG8_LDA(At, 0, 0); PG8_STAGE(PG8_SA(1, 1), a1 + hstep, voffA);
            PG8_WAIT_V(8); PG8_WAIT_L(0); PG8_BAR; PG8_MMA(0, 0, At, B0); PG8_MMA(0, 1, At, B1); PG8_BAR; PG8_SCHED;
            PG8_LDA(At, 0, 1); PG8_STAGE(PG8_SB(0, 0), b2, voffB); PG8_STAGE(PG8_SB(0, 1), b2 + hstep, voffB); PG8_STAGE(PG8_SA(0, 0), a2, voffA);
            PG8_WAIT_V(8); PG8_WAIT_L(0); PG8_BAR; PG8_MMA(1, 0, At, B0); PG8_MMA(1, 1, At, B1); PG8_BAR; PG8_SCHED;
            PG8_LDB(B0, 1, 0); PG8_LDB(B1, 1, 1); PG8_SCHED; PG8_LDA(At, 1, 0); PG8_STAGE(PG8_SA(0, 1), a2 + hstep, voffA);
            PG8_WAIT_V(8); PG8_WAIT_L(0); PG8_BAR; PG8_MMA(0, 0, At, B0); PG8_MMA(0, 1, At, B1); PG8_BAR; PG8_SCHED;
            PG8_LDA(At, 1, 1); PG8_STAGE(PG8_SB(1, 0), b3, voffB); PG8_STAGE(PG8_SB(1, 1), b3 + hstep, voffB); PG8_STAGE(PG8_SA(1, 0), a3, voffA);
            PG8_WAIT_V(8); PG8_WAIT_L(0); PG8_BAR; PG8_MMA(1, 0, At, B0); PG8_MMA(1, 1, At, B1); PG8_BAR; PG8_SCHED;
            } else {
            PG8_LDB(B0, 0, 0); PG8_SCHED; PG8_LDA(At, 0, 0); PG8_STAGE(PG8_SA(1, 1), a1 + hstep, voffA);
            PG8_WAIT_L(8); PG8_BAR; PG8_WAIT_L(0); PG8_MMA(0, 0, At, B0); PG8_BAR; PG8_SCHED;
            PG8_LDB(B1, 0, 1); PG8_STAGE(PG8_SB(0, 0), b2, voffB);
            PG8_BAR; PG8_WAIT_L(0); PG8_MMA(0, 1, At, B1); PG8_BAR;
            PG8_LDA(At, 0, 1); PG8_STAGE(PG8_SA(0, 0), a2, voffA);
            PG8_BAR; PG8_WAIT_L(0); PG8_MMA(1, 0, At, B0); PG8_BAR; PG8_SCHED;
            PG8_STAGE(PG8_SB(0, 1), b2 + hstep, voffB);
            PG8_WAIT_V(6); PG8_BAR; PG8_MMA(1, 1, At, B1); PG8_BAR;
            PG8_LDB(B0, 1, 0); PG8_SCHED; PG8_LDA(At, 1, 0); PG8_STAGE(PG8_SA(0, 1), a2 + hstep, voffA);
            PG8_WAIT_L(8); PG8_BAR; PG8_WAIT_L(0); PG8_MMA(0, 0, At, B0); PG8_BAR; PG8_SCHED;
            PG8_LDB(B1, 1, 1); PG8_STAGE(PG8_SB(1, 0), b3, voffB);
            PG8_BAR; PG8_WAIT_L(0); PG8_MMA(0, 1, At, B1); PG8_BAR;
            PG8_LDA(At, 1, 1); PG8_STAGE(PG8_SA(1, 0), a3, voffA);
            PG8_BAR; PG8_WAIT_L(0); PG8_MMA(1, 0, At, B0); PG8_BAR; PG8_SCHED;
            PG8_STAGE(PG8_SB(1, 1), b3 + hstep, voffB);
            PG8_WAIT_V(6); PG8_BAR; PG8_MMA(1, 1, At, B1); PG8_BAR;
            }
        }
        if constexpr (ALIGN_EPI) { if (wr == 0) PG8_BAR; }
        if constexpr (!Epi::AFTER_DRAIN) { E(acc, cur, wr, wc, fr, fq); S.done(cur); }
        if (!has_next) break;
#pragma unroll
        for (int a = 0; a < 2; ++a)
#pragma unroll
            for (int b = 0; b < 2; ++b)
#pragma unroll
                for (int m = 0; m < 4; ++m)
#pragma unroll
                    for (int n = 0; n < 2; ++n) acc[a][b][m][n] = (f32x4){0.f, 0.f, 0.f, 0.f};
        cur = nxt; cA = nA; cB = nB; ++ui;
        if constexpr (ALIGN_EPI) { if (wr == 1) PG8_BAR; }
    }
    PG8_WAIT_V(0);
    if constexpr (!ALIGN_EPI) { if (wr == 0) PG8_BAR; }
    PG8_BAR;
    if constexpr (Epi::AFTER_DRAIN) { E.fused(acc, cur, wr, wc, fr, fq, lds, wid, lane); S.done(cur); }
#undef PG8_SA
#undef PG8_SB
#undef PG8_STAGE
#undef PG8_LDA
#undef PG8_LDB
#undef PG8_MMA
#undef PG8_WAIT_V
#undef PG8_WAIT_L
#undef PG8_BAR
#undef PG8_SCHED
}
}
namespace pg8 {
struct EpiAxpyF32 {
    static constexpr bool PERM = false, AFTER_DRAIN = false;
    const float* base; float* out; int ldc; float alpha;
    __device__ __forceinline__ void operator()(const f32x4 (&acc)[2][2][4][2], const Unit& u, int wr, int wc, int fr, int fq) const {
        const int row0 = u.pm * BM + wr * 64 + fr, col0 = u.pn * BM + wc * 32 + 4 * fq;
#pragma unroll
        for (int ai = 0; ai < 2; ++ai)
#pragma unroll
            for (int m = 0; m < 4; ++m) { const size_t ro = (size_t)(row0 + ai * HALF + m * 16) * ldc + col0;
#pragma unroll
                for (int bj = 0; bj < 2; ++bj)
#pragma unroll
                    for (int n = 0; n < 2; ++n) { const size_t off = ro + bj * HALF + n * 16; const f32x4 b = *(const f32x4*)(base + off); *(f32x4*)(out + off) = b * alpha + acc[ai][bj][m][n]; } }
    }
};
}

#define LAS __attribute__((address_space(3)))
typedef unsigned short bf16_t;
typedef short bf16x8 __attribute__((ext_vector_type(8)));
typedef short s16x4 __attribute__((ext_vector_type(4)));
typedef float f32x2 __attribute__((ext_vector_type(2)));
typedef float f32x4 __attribute__((ext_vector_type(4)));
typedef float f32x16 __attribute__((ext_vector_type(16)));
typedef unsigned u32x2 __attribute__((ext_vector_type(2)));
typedef unsigned u32x4 __attribute__((ext_vector_type(4)));
typedef __bf16 bf16x2v __attribute__((ext_vector_type(2)));

constexpr int T_TOK = 49152, DM = 1024, NPROJ = 3072, DFF = 2816, NFF = 5632, HYW = 512;
constexpr int L_P = 2048, L_S = 4096, TOK_P = 32768;
constexpr int CHUNK = 16384, NCHUNK = 3;
constexpr float ALPHA_F = 1.189207115002721f;
constexpr float LN_EPS_F = 1e-5f, RMS_EPS_F = 1e-6f;
constexpr size_t MiB = 1u << 20;
constexpr size_t WS_WIN = 2 * MiB, WS_WOUT = 8 * MiB, WS_WF1 = 10 * MiB, WS_WF2 = 22 * MiB;
constexpr size_t WS_FILT_P = 28 * MiB, WS_FILT_S = 36 * MiB;
constexpr size_t WS_XB = 52 * MiB;
constexpr size_t WS_PROJ = 148 * MiB;
constexpr size_t WS_X1B = 148 * MiB, WS_U = 244 * MiB, WS_HID = 420 * MiB;
constexpr size_t WS_NEED = 508 * MiB;
constexpr int LDS_BYTES = 147456;

__device__ __forceinline__ unsigned pk2(float a, float b) { f32x2 v = {a, b}; bf16x2v r = __builtin_convertvector(v, bf16x2v); return __builtin_bit_cast(unsigned, r); }
__device__ __forceinline__ float bf2f(unsigned short h) { return __builtin_bit_cast(float, (unsigned)h << 16); }
__device__ __forceinline__ float bflo(unsigned w) { return __builtin_bit_cast(float, w << 16); }
__device__ __forceinline__ float bfhi(unsigned w) { return __builtin_bit_cast(float, w & 0xffff0000u); }
#define MFMA32(a, b, c) __builtin_amdgcn_mfma_f32_32x32x16_bf16((a), (b), (c), 0, 0, 0)
#define LDS_WAIT() asm volatile("s_waitcnt lgkmcnt(0)" ::: "memory")
__device__ __forceinline__ int crow(int reg, int h) { return (reg & 3) + 8 * (reg >> 2) + 4 * h; }
__device__ __forceinline__ float sin_turns(float tr) { tr = tr - floorf(tr); return __builtin_amdgcn_sinf(tr); }
__device__ __forceinline__ float fast_sin(float x) { return sin_turns(x * 0.15915494309189535f); }
__device__ __forceinline__ float wave_sum(float v) {
#pragma unroll
    for (int o = 1; o < 64; o <<= 1) v += __shfl_xor(v, o);
    return v;
}

#define XB_TMO      128
#define XB_XCNT(j)  (256  + 64 * (j))
#define XB_XSUB(j)  (1280 + 64 * (j))
#define XB_XGEN(j)  (2304 + 64 * (j))
#define XB_TOP      3328
#define XB_TOPGEN   3392
#define XCD_BAR_WORDS 3456
#define XB_SPIN_CAP (1u << 18)

__device__ __forceinline__ unsigned xb_ld(unsigned* p)              { return __hip_atomic_load(p, __ATOMIC_RELAXED, __HIP_MEMORY_SCOPE_AGENT); }
__device__ __forceinline__ unsigned xb_add(unsigned* p, unsigned v) { return __hip_atomic_fetch_add(p, v, __ATOMIC_RELAXED, __HIP_MEMORY_SCOPE_AGENT); }
__device__ __forceinline__ unsigned xb_xcc_id() { return (unsigned)__builtin_amdgcn_s_getreg((3 << 11) | 20) & 0xFu; }
#define XB_SPIN(cond, bar) do { unsigned _sp = 0; while (cond) { __builtin_amdgcn_s_sleep(1); \
    if ((++_sp & 255u) == 0u) { if (xb_ld(&(bar)[XB_TMO])) break; if (_sp > XB_SPIN_CAP) { atomicAdd(&(bar)[XB_TMO], 1u); break; } } } } while (0)

struct XcdBarrier {
    unsigned* bar; unsigned x;
    volatile LAS unsigned* st;
};

__device__ __forceinline__ XcdBarrier xcd_barrier_post(unsigned* bar, volatile LAS unsigned* st) {
    XcdBarrier b; b.bar = bar; b.x = xb_xcc_id(); b.st = st;
    if (threadIdx.x == 0) (void)xb_add(&bar[XB_XCNT(b.x)], 1u);
    return b;
}
__device__ __forceinline__ void xcd_barrier_complete(unsigned* bar, unsigned x, unsigned& nloc, unsigned& nx) {
    const unsigned G = gridDim.x * gridDim.y * gridDim.z;
    unsigned sum, cnt, mine, sp = 0u;
    for (;;) {
        sum = 0u; cnt = 0u; mine = 0u;
#pragma unroll
        for (unsigned j = 0; j < 16; ++j) { const unsigned c = xb_ld(&bar[XB_XCNT(j)]); sum += c; cnt += (c > 0u) ? 1u : 0u; mine = (j == x) ? c : mine; }
        if (sum == G) break;
        __builtin_amdgcn_s_sleep(1);
        if ((++sp & 255u) == 0u) { if (xb_ld(&bar[XB_TMO])) break; if (sp > XB_SPIN_CAP) { atomicAdd(&bar[XB_TMO], 1u); break; } }
    }
    nloc = mine > 0u ? mine : 1u; nx = cnt > 0u ? cnt : 1u;
}

__device__ __forceinline__ void xcd_barrier(const XcdBarrier& b) {
    asm volatile("s_waitcnt vmcnt(0)" ::: "memory");
    __syncthreads();
    if (threadIdx.x == 0) {
        unsigned* bar = b.bar;
        __builtin_amdgcn_s_waitcnt(0);
        unsigned nloc = b.st[0], nx = b.st[1];
        if (nloc == 0u) { xcd_barrier_complete(bar, b.x, nloc, nx); b.st[0] = nloc; b.st[1] = nx; }
        const unsigned old = xb_add(&bar[XB_XSUB(b.x)], 1u);
        const unsigned gen = old / nloc;
        if (old + 1u == (gen + 1u) * nloc) {
            __builtin_amdgcn_fence(__ATOMIC_RELEASE, "agent");
            asm volatile("s_waitcnt vmcnt(0)" ::: "memory");
            const unsigned og = xb_add(&bar[XB_TOP], 1u);
            const unsigned tg = og / nx;
            if (og + 1u == (tg + 1u) * nx) xb_add(&bar[XB_TOPGEN], 1u);
            else XB_SPIN(xb_ld(&bar[XB_TOPGEN]) == tg, bar);
            __builtin_amdgcn_fence(__ATOMIC_ACQUIRE, "agent");
            xb_add(&bar[XB_XGEN(b.x)], 1u);
            asm volatile("s_waitcnt vmcnt(0)" ::: "memory");
        } else {
            XB_SPIN(xb_ld(&bar[XB_XGEN(b.x)]) == gen, bar);
            __builtin_amdgcn_fence(__ATOMIC_ACQUIRE, "agent");
            asm volatile("s_waitcnt vmcnt(0)" ::: "memory");
        }
    }
    __syncthreads();
}

struct Args { const float* in[24]; float* out; unsigned char* ws; int ph_lo, ph_hi, li, pad; };
enum { I_XP = 0, I_XS, I_WIN, I_SW, I_SB, I_RPB, I_FW1, I_FB1, I_FFREQ, I_FWI, I_FBI, I_FW3, I_FBIAS, I_GA, I_GH, I_WOUT, I_LN1G, I_LN1B, I_FFW1, I_FFCW, I_FFCB, I_FFW2, I_LN2G, I_LN2B };

__device__ __forceinline__ void p0_transpose_item(const float* W, int K, int N, bf16_t* WT, LAS float* scr, int item, int lane) {
    const int nblk = N / 32, kb = item / nblk, nb = item % nblk, k0 = 64 * kb, n0 = 32 * nb;
#pragma unroll 8
    for (int i = 0; i < 32; ++i) { const int kk = 2 * i + (lane >> 5); scr[kk * 33 + (lane & 31)] = W[(size_t)(k0 + kk) * N + n0 + (lane & 31)]; }
    LDS_WAIT();
    const int c = lane & 7;
#pragma unroll
    for (int j = 0; j < 4; ++j) { const int n = (lane >> 3) + 8 * j; const LAS float* s = scr + (8 * c) * 33 + n;
        u32x4 o; o.x = pk2(s[0 * 33], s[1 * 33]); o.y = pk2(s[2 * 33], s[3 * 33]); o.z = pk2(s[4 * 33], s[5 * 33]); o.w = pk2(s[6 * 33], s[7 * 33]);
        *(u32x4*)(WT + (size_t)(n0 + n) * K + k0 + 8 * c) = o; }
    LDS_WAIT();
}

template <int L>
__device__ __forceinline__ void filter_unit(const Args& A, bf16_t* Rg, LAS unsigned char* lds, int chunk, int tid) {
    constexpr int NP = 8;
    LAS float* Z = (LAS float*)lds;
    LAS float* H1 = Z + NP * 36;
    LAS float* H2 = H1 + NP * 65;
    const float* w1 = A.in[I_FW1]; const float* b1 = A.in[I_FB1]; const float* fq = A.in[I_FFREQ];
    const float* wi = A.in[I_FWI]; const float* bi = A.in[I_FBI]; const float* w3 = A.in[I_FW3];
    const int t0 = chunk * NP;
    if (tid < NP * 33) {
        const int p = tid / 33, f = tid % 33, t = t0 + p; float val;
        if (f == 0) val = (float)t / (float)(L - 1);
        else { const int k = (f - 1) & 15; const float fr = 1e-4f + (float)k * ((15.0f - 1e-4f) / 15.0f); const float tr = ((float)t / (float)L) * fr; val = (f <= 16) ? sin_turns(tr + 0.25f) : -sin_turns(tr); }
        Z[p * 36 + f] = val;
    }
    __syncthreads();
    const int p_ = tid >> 6, j_ = tid & 63; const float fqj = fq[j_];
    { float a = b1[j_];
#pragma unroll 3
      for (int f = 0; f < 33; ++f) a += Z[p_ * 36 + f] * w1[f * 64 + j_];
      H1[p_ * 65 + j_] = fast_sin(fqj * a); }
    __syncthreads();
    { float a = bi[j_];
#pragma unroll 8
      for (int f = 0; f < 64; ++f) a += H1[p_ * 65 + f] * wi[f * 64 + j_];
      H2[p_ * 65 + j_] = fast_sin(fqj * a); }
    __syncthreads();
    { float a = bi[64 + j_];
#pragma unroll 8
      for (int f = 0; f < 64; ++f) a += H2[p_ * 65 + f] * wi[4096 + f * 64 + j_];
      H1[p_ * 65 + j_] = fast_sin(fqj * a); }
    __syncthreads();
    const int c = tid;
    float af[NP], ab[NP];
#pragma unroll
    for (int p = 0; p < NP; ++p) { af[p] = 0.f; ab[p] = 0.f; }
#pragma unroll 4
    for (int k = 0; k < 64; ++k) { const float wf = w3[k * 1024 + c], wb = w3[k * 1024 + 512 + c];
#pragma unroll
        for (int p = 0; p < NP; ++p) { const float h = H1[p * 65 + k]; af[p] += h * wf; ab[p] += h * wb; } }
    const float MIN_DECAY = -3.0701134573253945f, MAX_DECAY = -15.350567286626973f;
    const float delta = fabsf(MIN_DECAY + (float)c * ((MAX_DECAY - MIN_DECAY) / 511.0f));
    bf16_t* c0 = Rg + (size_t)c * (4 * L); bf16_t* c1 = c0 + 2 * L;
#pragma unroll
    for (int p = 0; p < NP; ++p) { const int t = t0 + p; const float tl = (float)t / (float)(L - 1); const float dec = __expf(-tl * delta);
        const bf16_t hf = (bf16_t)(pk2(af[p] * dec, 0.f) & 0xffffu), hb = (bf16_t)(pk2(ab[p] * dec, 0.f) & 0xffffu);
        c0[L - t] = hf; c1[L - t - 1] = hf;
        if (t >= 1) { c0[L + t] = hb; c1[L + t - 1] = hb; } else { c0[0] = 0; c1[2 * L - 1] = 0; } }
    __syncthreads();
}

__device__ __forceinline__ void p0_prologue(const Args& A, LAS unsigned char* lds, int tid, int wave, int lane) {
    unsigned char* ws = A.ws;
    const int bx = blockIdx.x, G = gridDim.x;
    for (int u = bx; u < 768; u += G) { if (u < 256) filter_unit<L_P>(A, (bf16_t*)(ws + WS_FILT_P), lds, u, tid); else filter_unit<L_S>(A, (bf16_t*)(ws + WS_FILT_S), lds, u - 256, tid); }
    __syncthreads();
    LAS float* scr = (LAS float*)(lds + wave * 16384);
    const int gw = bx * 8 + wave, NGW = G * 8;
    constexpr int I1 = 16 * 96, I2 = 16 * 32, I3 = 16 * 176, I4 = 44 * 32;
    for (int it = gw; it < I1 + I2 + I3 + I4; it += NGW) {
        int r = it;
        if (r < I1) { p0_transpose_item(A.in[I_WIN], 1024, 3072, (bf16_t*)(ws + WS_WIN), scr, r, lane); continue; } r -= I1;
        if (r < I2) { p0_transpose_item(A.in[I_WOUT], 1024, 1024, (bf16_t*)(ws + WS_WOUT), scr, r, lane); continue; } r -= I2;
        if (r < I3) { p0_transpose_item(A.in[I_FFW1], 1024, 5632, (bf16_t*)(ws + WS_WF1), scr, r, lane); continue; } r -= I3;
        p0_transpose_item(A.in[I_FFW2], 2816, 1024, (bf16_t*)(ws + WS_WF2), scr, r, lane);
    }
    bf16_t* xb = (bf16_t*)(ws + WS_XB);
    for (int m = gw; m < T_TOK; m += NGW) {
        const float* xr = (m < TOK_P) ? (A.in[I_XP] + (size_t)m * DM) : (A.in[I_XS] + (size_t)(m - TOK_P) * DM);
        const f32x4* x4 = (const f32x4*)xr + lane; u32x2* o = (u32x2*)(xb + (size_t)m * DM) + lane;
#pragma unroll
        for (int j = 0; j < 4; ++j) { const f32x4 v = x4[64 * j]; u32x2 w; w.x = pk2(v.x, v.y); w.y = pk2(v.z, v.w); o[64 * j] = w; }
    }
}

__device__ __forceinline__ s16x4 tr_read(unsigned lds_addr) { s16x4 r; asm volatile("ds_read_b64_tr_b16 %0, %1\n\ts_waitcnt lgkmcnt(0)" : "=&v"(r) : "v"(lds_addr) : "memory"); return r; }

__device__ constexpr bool att_need(int QT, int kt, int i) { return QT == 0 ? (kt == 0 || i < 4) : (kt == 1 || i >= 12); }
template <int KT, int ST>
__device__ __forceinline__ void att_pv_step(const f32x16 (&s)[2], f32x16 (&o)[2], unsigned abase) {
    u32x4 w;
    w.x = pk2(s[KT][8 * ST + 0], s[KT][8 * ST + 1]); w.y = pk2(s[KT][8 * ST + 2], s[KT][8 * ST + 3]);
    w.z = pk2(s[KT][8 * ST + 4], s[KT][8 * ST + 5]); w.w = pk2(s[KT][8 * ST + 6], s[KT][8 * ST + 7]);
    const bf16x8 pf = __builtin_bit_cast(bf16x8, w);
    s16x4 l0, h0, l1, h1;
    constexpr int OFF = (32 * KT + 16 * ST) * 144;
    asm volatile("ds_read_b64_tr_b16 %0, %4 offset:%5\n\tds_read_b64_tr_b16 %1, %4 offset:%6\n\tds_read_b64_tr_b16 %2, %4 offset:%7\n\tds_read_b64_tr_b16 %3, %4 offset:%8\n\ts_waitcnt lgkmcnt(0)"
                 : "=&v"(l0), "=&v"(h0), "=&v"(l1), "=&v"(h1) : "v"(abase), "i"(OFF), "i"(OFF + 8 * 144), "i"(OFF + 64), "i"(OFF + 64 + 8 * 144) : "memory");
    const bf16x8 v0 = __builtin_shufflevector(l0, h0, 0, 1, 2, 3, 4, 5, 6, 7), v1 = __builtin_shufflevector(l1, h1, 0, 1, 2, 3, 4, 5, 6, 7);
    o[0] = MFMA32(v0, pf, o[0]); o[1] = MFMA32(v1, pf, o[1]);
}
template <int QT>
__device__ __forceinline__ void attn_pass(const bf16_t* proj, const LAS float* bl, LAS unsigned char* vl, int tok0, int seqbase, int r, int r0, int h, int lane, LAS unsigned char* odst, float& ssout) {
    const int rr = lane & 31, hh = lane >> 5;
    bf16x8 qf[4];
#pragma unroll
    for (int ks = 0; ks < 4; ++ks) qf[ks] = *(const bf16x8*)(proj + (size_t)(tok0 + 32 * QT + rr) * NPROJ + 64 * h + 16 * ks + 8 * hh);
    f32x16 o[2];
#pragma unroll
    for (int a = 0; a < 2; ++a)
#pragma unroll
        for (int i = 0; i < 16; ++i) o[a][i] = 0.f;
    float m_run = 0.f, lsum = 0.f;
    const int i16 = lane & 15, tq = i16 >> 2, tp = i16 & 3, blk = (lane >> 4) & 1;
    const unsigned abase = (unsigned)(size_t)vl + (unsigned)((4 * hh + tq) * 144 + 32 * blk + 8 * tp);
    const int qc = 32 * QT + rr, cs = min(max(qc - 8, 0), 48), xm = 4 * hh - cs;
    const LAS float* blane = bl + 64 + 15 + 4 * hh - qc;
    const bf16_t* kbase = proj + (size_t)(seqbase + 64 * r0 + rr) * NPROJ + 512 + 64 * h + 8 * hh;
    const bf16_t* vgbase = proj + (size_t)(seqbase + 64 * r0 + (lane >> 3)) * NPROJ + 1024 + 64 * h + 8 * (lane & 7);
    LAS unsigned char* vst = vl + (lane >> 3) * 144 + 16 * (lane & 7);
    bf16x8 Kc[2][4]; u32x4 Vr[8];
#pragma unroll
    for (int kt = 0; kt < 2; ++kt)
#pragma unroll
        for (int ks = 0; ks < 4; ++ks) Kc[kt][ks] = *(const bf16x8*)(kbase + (size_t)(32 * kt) * NPROJ + 16 * ks);
#pragma unroll
    for (int i = 0; i < 8; ++i) Vr[i] = *(const u32x4*)(vgbase + (size_t)(8 * i) * NPROJ);
#pragma unroll
    for (int i = 0; i < 8; ++i) *(LAS u32x4*)(vst + 8 * i * 144) = Vr[i];
    LDS_WAIT();
#pragma unroll 1
    for (int kr = 0; kr < 8; ++kr) {
        f32x16 s[2];
#pragma unroll
        for (int a = 0; a < 2; ++a)
#pragma unroll
            for (int i = 0; i < 16; ++i) s[a][i] = 0.f;
#pragma unroll
        for (int kt = 0; kt < 2; ++kt)
#pragma unroll
            for (int ks = 0; ks < 4; ++ks) s[kt] = MFMA32(Kc[kt][ks], qf[ks], s[kt]);
        if (kr < 7) {
            const size_t adv = (size_t)(64 * (kr + 1)) * NPROJ;
#pragma unroll
            for (int kt = 0; kt < 2; ++kt)
#pragma unroll
                for (int ks = 0; ks < 4; ++ks) Kc[kt][ks] = *(const bf16x8*)(kbase + adv + (size_t)(32 * kt) * NPROJ + 16 * ks);
#pragma unroll
            for (int i = 0; i < 8; ++i) Vr[i] = *(const u32x4*)(vgbase + adv + (size_t)(8 * i) * NPROJ);
        }
        const int dr = r0 + kr - r + 7; const LAS float* brow = blane + dr * 31;
        const float C1 = 0.125f * 1.4426950408889634f;
        float mx = -1e30f;
#pragma unroll
        for (int kt = 0; kt < 2; ++kt)
#pragma unroll
            for (int i = 0; i < 16; ++i) if (att_need(QT, kt, i)) { const int ce = 32 * kt + (i & 3) + 8 * (i >> 2);
                const bool valid = (unsigned)(xm + ce) < 16u;
                const float bval = brow[ce]; const float sv = s[kt][i] * C1 + bval;
                const float v = valid ? sv : -INFINITY; s[kt][i] = v; mx = fmaxf(mx, v); }
        mx = fmaxf(mx, __shfl_xor(mx, 32));
        if (kr == 0) m_run = mx;
        else if (__any(mx > m_run + 8.0f)) { const float mnew = fmaxf(m_run, mx), alpha = __builtin_amdgcn_exp2f(m_run - mnew); lsum *= alpha; m_run = mnew;
#pragma unroll
            for (int dt = 0; dt < 2; ++dt)
#pragma unroll
                for (int i = 0; i < 16; ++i) o[dt][i] *= alpha; }
#pragma unroll
        for (int kt = 0; kt < 2; ++kt)
#pragma unroll
            for (int i = 0; i < 16; ++i) { if (att_need(QT, kt, i)) { const float p = __builtin_amdgcn_exp2f(s[kt][i] - m_run); s[kt][i] = p; lsum += p; } else s[kt][i] = 0.f; }
        if (QT == 0) { att_pv_step<0, 0>(s, o, abase); att_pv_step<0, 1>(s, o, abase); att_pv_step<1, 0>(s, o, abase); }
        else { att_pv_step<0, 1>(s, o, abase); att_pv_step<1, 0>(s, o, abase); att_pv_step<1, 1>(s, o, abase); }
        if (kr < 7) {
#pragma unroll
            for (int i = 0; i < 8; ++i) *(LAS u32x4*)(vst + 8 * i * 144) = Vr[i];
            LDS_WAIT();
        }
    }
    const float l_run = lsum + __shfl_xor(lsum, 32);
    const float inv = 1.0f / l_run; float ss = 0.f;
#pragma unroll
    for (int dt = 0; dt < 2; ++dt)
#pragma unroll
        for (int g = 0; g < 4; ++g) { const float v0 = o[dt][4 * g] * inv, v1 = o[dt][4 * g + 1] * inv, v2 = o[dt][4 * g + 2] * inv, v3 = o[dt][4 * g + 3] * inv;
            ss += (v0 * v0 + v1 * v1) + (v2 * v2 + v3 * v3); u32x2 w; w.x = pk2(v0, v1); w.y = pk2(v2, v3);
            *(LAS u32x2*)(odst + rr * 144 + 2 * (32 * dt + 8 * g + 4 * hh)) = w; }
    ss += __shfl_xor(ss, 32);
    ssout = ss;
}

__device__ __forceinline__ void attn_unit(const bf16_t* proj, const float* rpb, const float* g_attn, bf16_t* merged, LAS unsigned char* lds, int u, int wave, int lane) {
    const int tok0 = 64 * u; int rows, r, seqbase;
    if (u < 512) { rows = 32; r = u & 31; seqbase = (u >> 5) * 2048; } else { const int v = u - 512; rows = 64; r = v & 63; seqbase = TOK_P + (v >> 6) * 4096; }
    const int r0 = min(max(r - 4, 0), rows - 8);
    const int h = wave, rr = lane & 31, hh = lane >> 5;
    LAS unsigned char* vl = lds + wave * 9216;
    LAS float* bl = (LAS float*)(lds + 73728 + wave * 2432);
    LAS float* ssq = (LAS float*)(lds + 73728 + 8 * 2432);
    for (int i = lane; i < 608; i += 64) { const int j = i - 64; bl[i] = (j >= 0 && j < 465) ? rpb[h * 465 + j] * 1.4426950408889634f : 0.f; }
    LDS_WAIT();
    LAS unsigned char* ost0 = lds + 95232 + wave * 4608;
    float ss0, ss1;
    attn_pass<0>(proj, bl, vl, tok0, seqbase, r, r0, h, lane, ost0, ss0);
    attn_pass<1>(proj, bl, vl, tok0, seqbase, r, r0, h, lane, vl + 32 * 144, ss1);
    if (hh == 0) { ssq[wave * 64 + rr] = ss0; ssq[wave * 64 + 32 + rr] = ss1; }
    __syncthreads();
    float tot = 0.f;
#pragma unroll
    for (int w = 0; w < 8; ++w) tot += ssq[w * 64 + lane];
    const float rs = 1.0f / sqrtf(tot * (1.0f / 512.0f) + RMS_EPS_F);
    const f32x4 g0 = *(const f32x4*)(g_attn + 64 * h + 8 * (lane & 7)), g1 = *(const f32x4*)(g_attn + 64 * h + 8 * (lane & 7) + 4);
#pragma unroll
    for (int i = 0; i < 8; ++i) { const int q = (lane >> 3) + 8 * i; const float rq = __shfl(rs, q);
        const LAS unsigned char* src = (i < 4 ? ost0 + q * 144 : vl + q * 144) + 16 * (lane & 7);
        const u32x4 v = *(const LAS u32x4*)src; u32x4 w;
        w.x = pk2(bflo(v.x) * rq * g0.x, bfhi(v.x) * rq * g0.y); w.y = pk2(bflo(v.y) * rq * g0.z, bfhi(v.y) * rq * g0.w);
        w.z = pk2(bflo(v.z) * rq * g1.x, bfhi(v.z) * rq * g1.y); w.w = pk2(bflo(v.w) * rq * g1.z, bfhi(v.w) * rq * g1.w);
        *(u32x4*)(merged + (size_t)(tok0 + q) * DM + 64 * h + 8 * (lane & 7)) = w; }
    __syncthreads();
}

__device__ __forceinline__ void hyprep_unit(const bf16_t* proj, const float* sw, const float* sb, bf16_t* vT, bf16_t* x0T, LAS unsigned char* lds, int u, int tid) {
    const int tok0 = 64 * u; int L, s_tile, seqbase;
    if (u < 512) { L = 2048; s_tile = (u & 31) * 64; seqbase = (u >> 5) * 2048; } else { const int v = u - 512; L = 4096; s_tile = (v & 63) * 64; seqbase = TOK_P + (v >> 6) * 4096; }
    LAS unsigned* VL = (LAS unsigned*)lds;
    LAS unsigned* XL = VL + 512 * 33;
    const int tslot = tid >> 7, cgp = tid & 127, c = 4 * cgp;
    f32x4 w[3][3], bb[3];
#pragma unroll
    for (int st = 0; st < 3; ++st) {
#pragma unroll
        for (int k = 0; k < 3; ++k) w[st][k] = *(const f32x4*)(sw + k * 1536 + st * 512 + c);
        bb[st] = *(const f32x4*)(sb + st * 512 + c); }
#pragma unroll 1
    for (int half = 0; half < 2; ++half) {
        const int tb = 16 * tslot + 8 * half;
        const int sbeg = s_tile + tb;
        const bf16_t* pbase = proj + (size_t)(tok0 + tb) * NPROJ + 1536 + c;
        u32x2 raw[10][3];
#pragma unroll
        for (int rI = 0; rI < 10; ++rI) { const int sp = sbeg + rI - 1; const bool ok = (sp >= 0) && (sp < L);
#pragma unroll
            for (int st = 0; st < 3; ++st) { u32x2 t = {0u, 0u}; if (ok) t = *(const u32x2*)(pbase + (ptrdiff_t)(rI - 1) * NPROJ + st * 512); raw[rI][st] = t; } }
        f32x4 vprev, xprev;
#pragma unroll
        for (int i = 0; i < 8; ++i) {
            f32x4 uc[3];
#pragma unroll
            for (int st = 0; st < 3; ++st) {
                const f32x4 p0 = {bflo(raw[i][st].x), bfhi(raw[i][st].x), bflo(raw[i][st].y), bfhi(raw[i][st].y)};
                const f32x4 p1 = {bflo(raw[i + 1][st].x), bfhi(raw[i + 1][st].x), bflo(raw[i + 1][st].y), bfhi(raw[i + 1][st].y)};
                const f32x4 p2 = {bflo(raw[i + 2][st].x), bfhi(raw[i + 2][st].x), bflo(raw[i + 2][st].y), bfhi(raw[i + 2][st].y)};
                uc[st] = w[st][0] * p0 + w[st][1] * p1 + w[st][2] * p2 + bb[st]; }
            const f32x4 vv = uc[2] * uc[1];
            if (i & 1) { const int tp = (tb + i) >> 1;
#pragma unroll
                for (int e = 0; e < 4; ++e) { VL[(c + e) * 33 + tp] = pk2(vprev[e], vv[e]); XL[(c + e) * 33 + tp] = pk2(xprev[e], uc[0][e]); } }
            vprev = vv; xprev = uc[0];
        }
    }
    __syncthreads();
    const size_t obase = (size_t)512 * seqbase + s_tile;
    for (int it = tid; it < 2 * 512 * 8; it += 512) { const int arr = it >> 12, row = (it >> 3) & 511, ch = it & 7;
        const LAS unsigned* src = (arr ? XL : VL) + row * 33 + 4 * ch; u32x4 v; v.x = src[0]; v.y = src[1]; v.z = src[2]; v.w = src[3];
        *(u32x4*)((arr ? x0T : vT) + obase + (size_t)row * L + 8 * ch) = v; }
    __syncthreads();
}

template <int L, int B>
__device__ __forceinline__ void toeplitz_unit(const bf16_t* Rg, const bf16_t* vT, bf16_t* hyT, const bf16_t* x0T, const float* fbias, LAS unsigned char* lds, int c, size_t kind_base, int tid, int wave, int lane) {
    constexpr int NB = L / 64, T1PT = 32 / B, PAD = T1PT - 1, NTILES = NB / T1PT, NTW = NTILES / 8;
    constexpr int VROWS = (NB + 2 * PAD) * B, VBYTES = VROWS * 144;
    LAS unsigned char* Vl = lds;
    LAS unsigned* E = (LAS unsigned*)(lds + VBYTES);
    LAS unsigned* O = E + L + 16;
    const bf16_t* vch = vT + kind_base + (size_t)c * L;
    bf16_t* hch = hyT + kind_base + (size_t)c * L;
    const bf16_t* xch = x0T + kind_base + (size_t)c * L;
    for (int idx = tid; idx < NB * B * 8; idx += 512) { const int ch = idx & 7, row = idx >> 3, b = row % B, s1 = row / B;
        const u32x4 v = *(const u32x4*)(vch + (size_t)b * 512 * L + 64 * s1 + 8 * ch);
        *(LAS u32x4*)(Vl + ((s1 + PAD) * B + b) * 144 + 16 * ch) = v; }
    for (int idx = tid; idx < 2 * PAD * B * 9; idx += 512) { const int ch = idx % 9, row = idx / 9; const int rrow = row < PAD * B ? row : (NB * B + row);
        *(LAS u32x4*)(Vl + rrow * 144 + 16 * ch) = (u32x4){0u, 0u, 0u, 0u}; }
    { const u32x4* src = (const u32x4*)(Rg + (size_t)c * 4 * L);
      for (int idx = tid; idx < L / 2; idx += 512) { const int cp = idx / (L / 4), k = idx % (L / 4); const u32x4 v = src[idx]; *(LAS u32x4*)((cp ? O : E) + 4 * k) = v; } }
    __syncthreads();
    const int rr = lane & 31, hh = lane >> 5;
    const LAS unsigned* fb = ((rr & 1) ? O : E) + ((L + 8 * hh - rr - (rr & 1)) >> 1);
    f32x16 acc[NTW][2];
#pragma unroll
    for (int i = 0; i < NTW; ++i)
#pragma unroll
        for (int m = 0; m < 2; ++m)
#pragma unroll
            for (int k = 0; k < 16; ++k) acc[i][m][k] = 0.f;
    const int t1l = rr / B, bcol = rr % B;
    const int dlo = T1PT * wave - (NB - 1), dhi = T1PT * (wave + 8 * (NTW - 1)) + T1PT - 1;
    for (int d = dlo; d <= dhi; ++d) {
        bf16x8 F[6];
#pragma unroll
        for (int q = 0; q < 6; ++q) { const LAS unsigned* p = fb - 8 * (4 * d - 3 + q); u32x4 w; w.x = p[0]; w.y = p[1]; w.z = p[2]; w.w = p[3]; F[q] = __builtin_bit_cast(bf16x8, w); }
#pragma unroll
        for (int i = 0; i < NTW; ++i) { const int j = wave + 8 * i;
            if (d >= T1PT * j - (NB - 1) && d <= T1PT * j + T1PT - 1) {
                const LAS unsigned char* vb = Vl + ((T1PT * j + t1l - d + PAD) * B + bcol) * 144 + 16 * hh;
#pragma unroll
                for (int kt = 0; kt < 4; ++kt) { const bf16x8 bf = *(const LAS bf16x8*)(vb + 32 * kt);
#pragma unroll
                    for (int mt = 0; mt < 2; ++mt) acc[i][mt] = MFMA32(F[2 * mt - kt + 3], bf, acc[i][mt]); }
            } }
    }
    const float fbv = fbias[c];
#pragma unroll
    for (int i = 0; i < NTW; ++i) { const int j = wave + 8 * i, t1 = T1PT * j + t1l;
#pragma unroll
        for (int mt = 0; mt < 2; ++mt)
#pragma unroll
            for (int g = 0; g < 4; ++g) { const int t0 = 32 * mt + 8 * g + 4 * hh;
                const u32x2 vv = *(const LAS u32x2*)(Vl + ((t1 + PAD) * B + bcol) * 144 + 2 * t0);
                const size_t go = (size_t)bcol * 512 * L + 64 * t1 + t0;
                const u32x2 xv = *(const u32x2*)(xch + go);
                const float y0 = (acc[i][mt][4 * g + 0] + fbv * bflo(vv.x)) * bflo(xv.x), y1 = (acc[i][mt][4 * g + 1] + fbv * bfhi(vv.x)) * bfhi(xv.x);
                const float y2 = (acc[i][mt][4 * g + 2] + fbv * bflo(vv.y)) * bflo(xv.y), y3 = (acc[i][mt][4 * g + 3] + fbv * bfhi(vv.y)) * bfhi(xv.y);
                u32x2 w; w.x = pk2(y0, y1); w.y = pk2(y2, y3);
                *(u32x2*)(hch + go) = w; } }
    __syncthreads();
}

__device__ __forceinline__ void hynorm_unit(const bf16_t* hyT, const float* g_hy, bf16_t* merged, LAS unsigned char* lds, int u, int tid, int wave, int lane) {
    const int tok0 = 64 * u; int L, s_tile, seqbase;
    if (u < 512) { L = 2048; s_tile = (u & 31) * 64; seqbase = (u >> 5) * 2048; } else { const int v = u - 512; L = 4096; s_tile = (v & 63) * 64; seqbase = TOK_P + (v >> 6) * 4096; }
    LAS unsigned char* HL = lds;
    LAS float* ssq = (LAS float*)(lds + 512 * 144);
    const size_t ibase = (size_t)512 * seqbase + s_tile;
    for (int it = tid; it < 512 * 8; it += 512) { const int row = it >> 3, ch = it & 7;
        *(LAS u32x4*)(HL + row * 144 + 16 * ch) = *(const u32x4*)(hyT + ibase + (size_t)row * L + 8 * ch); }
    __syncthreads();
    float ss = 0.f;
    const LAS unsigned short* col = (const LAS unsigned short*)(HL + (64 * wave) * 144) + lane;
#pragma unroll 8
    for (int k = 0; k < 64; ++k) { const float v = bf2f(col[k * 72]); ss += v * v; }
    ssq[wave * 64 + lane] = ss;
    __syncthreads();
    float tot = 0.f;
#pragma unroll
    for (int w = 0; w < 8; ++w) tot += ssq[w * 64 + lane];
    const float rs = 1.0f / sqrtf(tot * (1.0f / 512.0f) + RMS_EPS_F);
    bf16_t* orow = merged + (size_t)(tok0 + lane) * DM + 512 + 64 * wave;
#pragma unroll
    for (int k8 = 0; k8 < 8; ++k8) { float v[8];
#pragma unroll
        for (int e = 0; e < 8; ++e) v[e] = bf2f(col[(8 * k8 + e) * 72]) * rs * g_hy[64 * wave + 8 * k8 + e];
        u32x4 w; w.x = pk2(v[0], v[1]); w.y = pk2(v[2], v[3]); w.z = pk2(v[4], v[5]); w.w = pk2(v[6], v[7]);
        *(u32x4*)(orow + 8 * k8) = w; }
    __syncthreads();
}

__device__ __forceinline__ void ln_rows(float* io, bf16_t* ob, const float* g, const float* b, int gw, int NGW, int lane) {
    f32x4 gv[4], bv[4];
#pragma unroll
    for (int j = 0; j < 4; ++j) { gv[j] = ((const f32x4*)g)[lane + 64 * j]; bv[j] = ((const f32x4*)b)[lane + 64 * j]; }
    for (int m = gw; m < T_TOK; m += NGW) {
        f32x4* xr = (f32x4*)(io + (size_t)m * DM) + lane;
        f32x4 v[4]; float s = 0.f;
#pragma unroll
        for (int j = 0; j < 4; ++j) { v[j] = xr[64 * j]; s += (v[j].x + v[j].y) + (v[j].z + v[j].w); }
        const float mean = wave_sum(s) * (1.f / DM); float s2 = 0.f;
#pragma unroll
        for (int j = 0; j < 4; ++j) { v[j] = v[j] - mean; s2 += (v[j].x * v[j].x + v[j].y * v[j].y) + (v[j].z * v[j].z + v[j].w * v[j].w); }
        const float rstd = 1.f / sqrtf(wave_sum(s2) * (1.f / DM) + LN_EPS_F);
#pragma unroll
        for (int j = 0; j < 4; ++j) { const f32x4 y = v[j] * rstd * gv[j] + bv[j]; xr[64 * j] = y;
            if (ob) { u32x2 w; w.x = pk2(y.x, y.y); w.y = pk2(y.z, y.w); ((u32x2*)(ob + (size_t)m * DM))[lane + 64 * j] = w; } }
    }
}

__device__ __forceinline__ void convgelu_chunk(const bf16_t* U, bf16_t* H, const float* cw, const float* cb, int L, int gtid, int nthreads) {
    constexpr int NG = DFF / 4, RUN = 16;
    const int nitems = (CHUNK / RUN) * NG;
    for (int it = gtid; it < nitems; it += nthreads) {
        const int g = it % NG, run = it / NG, c = 4 * g, t0 = run * RUN, s0 = t0 % L;
        f32x4 wa[3], wg[3];
#pragma unroll
        for (int k = 0; k < 3; ++k) { wa[k] = *(const f32x4*)(cw + k * NFF + c); wg[k] = *(const f32x4*)(cw + k * NFF + DFF + c); }
        const f32x4 ba = *(const f32x4*)(cb + c), bg = *(const f32x4*)(cb + DFF + c);
        const bf16_t* ua = U + (size_t)t0 * NFF + c; const bf16_t* ug = ua + DFF;
        f32x4 pa, pg, ca, cg_, na, ng;
        { u32x2 a = {0u, 0u}, b = {0u, 0u}; if (s0 > 0) { a = *(const u32x2*)(ua - NFF); b = *(const u32x2*)(ug - NFF); }
          pa = (f32x4){bflo(a.x), bfhi(a.x), bflo(a.y), bfhi(a.y)}; pg = (f32x4){bflo(b.x), bfhi(b.x), bflo(b.y), bfhi(b.y)};
          a = *(const u32x2*)(ua); b = *(const u32x2*)(ug);
          ca = (f32x4){bflo(a.x), bfhi(a.x), bflo(a.y), bfhi(a.y)}; cg_ = (f32x4){bflo(b.x), bfhi(b.x), bflo(b.y), bfhi(b.y)}; }
#pragma unroll 4
        for (int i = 0; i < RUN; ++i) {
            u32x2 a = {0u, 0u}, b = {0u, 0u}; if (s0 + i + 1 < L) { a = *(const u32x2*)(ua + (size_t)(i + 1) * NFF); b = *(const u32x2*)(ug + (size_t)(i + 1) * NFF); }
            na = (f32x4){bflo(a.x), bfhi(a.x), bflo(a.y), bfhi(a.y)}; ng = (f32x4){bflo(b.x), bfhi(b.x), bflo(b.y), bfhi(b.y)};
            const f32x4 va = wa[0] * pa + wa[1] * ca + wa[2] * na + ba, vg = wg[0] * pg + wg[1] * cg_ + wg[2] * ng + bg;
            const pg8::f32x2 g01 = pg8::gelu_pk((pg8::f32x2){vg[0], vg[1]}), g23 = pg8::gelu_pk((pg8::f32x2){vg[2], vg[3]});
            const f32x4 hv = va * (f32x4){g01.x, g01.y, g23.x, g23.y};
            u32x2 w; w.x = pk2(hv[0], hv[1]); w.y = pk2(hv[2], hv[3]);
            *(u32x2*)(H + (size_t)(t0 + i) * DFF + c) = w;
            pa = ca; pg = cg_; ca = na; cg_ = ng;
        }
    }
}

constexpr int NPHASE = 15;
__global__ void __launch_bounds__(512) fwd_kernel(Args A) {
    extern __shared__ __attribute__((aligned(16))) unsigned char lds_raw[];
    LAS unsigned char* lds = (LAS unsigned char*)lds_raw;
    cg::grid_group grid = cg::this_grid();
    const int tid = threadIdx.x, lane = tid & 63, wave = __builtin_amdgcn_readfirstlane(tid >> 6);
    const int bx = blockIdx.x, G = gridDim.x;
    unsigned char* ws = A.ws;
    bf16_t* xb = (bf16_t*)(ws + WS_XB); bf16_t* merged = xb;
    bf16_t* proj = (bf16_t*)(ws + WS_PROJ);
    bf16_t* vT = (bf16_t*)A.out; bf16_t* x0T = vT + (size_t)T_TOK * HYW; bf16_t* hyT = x0T + (size_t)T_TOK * HYW;
    bf16_t* x1b = (bf16_t*)(ws + WS_X1B); bf16_t* ubuf = (bf16_t*)(ws + WS_U); bf16_t* hbuf = (bf16_t*)(ws + WS_HID);
    const int lo = A.ph_lo, hi = A.ph_hi;
    volatile LAS unsigned* bst = (volatile LAS unsigned*)(lds + LDS_BYTES - 64);
    if (tid < 16) bst[tid] = 0u;
    __syncthreads();
    XcdBarrier xbar = xcd_barrier_post((unsigned*)ws + A.li * XCD_BAR_WORDS, bst);
#ifndef PHASE_MASK
#define PHASE_MASK 0x7fff
#endif
#define IN(k) (((PHASE_MASK >> (k)) & 1) && lo <= (k) && (k) < hi)
#ifndef DUP_PHASE
#define DUP_PHASE -1
#endif
#define REPS(k)
#ifndef CG_SEAMS
#define CG_SEAMS 1
#endif
#define SEAM(k) do { if (IN(k) && IN((k) + 1)) { if ((k) < CG_SEAMS) grid.sync(); else xcd_barrier(xbar); } } while (0)
#ifdef EXTRA_SYNCS
    for (int i_ = 0; i_ < EXTRA_SYNCS; ++i_) grid.sync();
#endif
    if (IN(0)) REPS(0) { p0_prologue(A, lds, tid, wave, lane); }
    SEAM(0);
    if (IN(1)) REPS(1) { pg8::Gemm g{xb, (const bf16_t*)(ws + WS_WIN), T_TOK, NPROJ, DM}; pg8::StaticOrder S; S.init(T_TOK, NPROJ, G, bx);
        pg8::EpiBf16<0> E{proj, NPROJ, nullptr, 0, 0, 1.f};
        pg8::gemm_phase<pg8::EpiBf16<0>, pg8::StaticOrder, true, true>(lds, g, S, E); }
    SEAM(1);
    if (IN(2)) {
#ifndef ATT_REPS
#define ATT_REPS 1
#endif
        for (int rep_ = 0; rep_ < ATT_REPS; ++rep_) { if (G == 256) { for (int i = 0; i < 3; ++i) attn_unit(proj, A.in[I_RPB], A.in[I_GA], merged, lds, 96 * (bx & 7) + (bx >> 3) + 32 * i, wave, lane); }
            else { for (int u = bx; u < 768; u += G) attn_unit(proj, A.in[I_RPB], A.in[I_GA], merged, lds, u, wave, lane); } }
        REPS(20) for (int u = bx; u < 768; u += G) hyprep_unit(proj, A.in[I_SW], A.in[I_SB], vT, x0T, lds, u, tid);
    }
    SEAM(2);
    if (IN(3)) {
        REPS(3) for (int u = bx; u < 1024; u += G) {
            if (u < 512) toeplitz_unit<L_P, 16>((const bf16_t*)(ws + WS_FILT_P), vT, hyT, x0T, A.in[I_FBIAS], lds, u, 0, tid, wave, lane);
            else toeplitz_unit<L_S, 4>((const bf16_t*)(ws + WS_FILT_S), vT, hyT, x0T, A.in[I_FBIAS], lds, u - 512, (size_t)512 * TOK_P, tid, wave, lane);
        }
    }
    SEAM(3);
    if (IN(4)) REPS(4) { for (int u = bx; u < 768; u += G) hynorm_unit(hyT, A.in[I_GH], merged, lds, u, tid, wave, lane); }
    SEAM(4);
    if (IN(5)) REPS(5) {
        { pg8::Gemm g{merged, (const bf16_t*)(ws + WS_WOUT), TOK_P, DM, DM}; pg8::StaticOrder S; S.init(TOK_P, DM, G, bx);
          pg8::EpiAxpyF32 E{A.in[I_XP], A.out, DM, ALPHA_F};
          pg8::gemm_phase<pg8::EpiAxpyF32, pg8::StaticOrder, true, true>(lds, g, S, E); }
        { pg8::Gemm g{merged + (size_t)TOK_P * DM, (const bf16_t*)(ws + WS_WOUT), T_TOK - TOK_P, DM, DM}; pg8::StaticOrder S; S.init(T_TOK - TOK_P, DM, G, bx);
          pg8::EpiAxpyF32 E{A.in[I_XS], A.out + (size_t)TOK_P * DM, DM, ALPHA_F};
          pg8::gemm_phase<pg8::EpiAxpyF32, pg8::StaticOrder, true, true>(lds, g, S, E); }
    }
    SEAM(5);
    if (IN(6)) ln_rows(A.out, x1b, A.in[I_LN1G], A.in[I_LN1B], bx * 8 + wave, G * 8, lane);
    SEAM(6);
#pragma unroll
    for (int k = 0; k < NCHUNK + 1; ++k) {
        const int ph = 7 + 2 * k;
        if (IN(ph)) {
            if (k >= 1) { pg8::Gemm g{hbuf, (const bf16_t*)(ws + WS_WF2), CHUNK, DM, DFF}; pg8::StaticOrder S; S.init(CHUNK, DM, G, bx);
                float* o = A.out + (size_t)(k - 1) * CHUNK * DM; pg8::EpiAxpyF32 E{o, o, DM, ALPHA_F};
                pg8::gemm_phase<pg8::EpiAxpyF32, pg8::StaticOrder, true, true>(lds, g, S, E); }
            if (k < NCHUNK) REPS(7 + 100 * k) { pg8::Gemm g{x1b + (size_t)k * CHUNK * DM, (const bf16_t*)(ws + WS_WF1), CHUNK, NFF, DM}; pg8::StaticOrder S; S.init(CHUNK, NFF, G, bx);
                pg8::EpiBf16<0> E{ubuf, NFF, nullptr, 0, 0, 1.f};
                pg8::gemm_phase<pg8::EpiBf16<0>, pg8::StaticOrder, true, true>(lds, g, S, E); }
        }
        SEAM(ph);
        if (k < NCHUNK) {
            if (IN(ph + 1)) REPS(8 + 100 * k) convgelu_chunk(ubuf, hbuf, A.in[I_FFCW], A.in[I_FFCB], k < 2 ? L_P : L_S, bx * 512 + tid, G * 512);
            SEAM(ph + 1);
        }
    }
    if (IN(14)) ln_rows(A.out, nullptr, A.in[I_LN2G], A.in[I_LN2B], bx * 8 + wave, G * 8, lane);
#undef IN
#undef SEAM
}

#ifndef MK_PER_PHASE
#define MK_PER_PHASE 0
#endif
extern "C" void kernel_launch(void* const* d_in, const int* in_sizes, int n_in, void* d_out, int out_size, void* d_ws, size_t ws_size, hipStream_t stream) {
    static int grid = 0;
    if (grid == 0) {
        if (n_in != 24 || out_size != T_TOK * DM || ws_size < WS_NEED) { fprintf(stderr, "kernel_launch: unexpected shapes n_in %d out %d ws %zu\n", n_in, out_size, ws_size); grid = -1; return; }
        int dev = 0, cus = 0, per_cu = 0;
        hipGetDevice(&dev); hipDeviceGetAttribute(&cus, hipDeviceAttributeMultiprocessorCount, dev);
        if (hipFuncSetAttribute((const void*)fwd_kernel, hipFuncAttributeMaxDynamicSharedMemorySize, LDS_BYTES) != hipSuccess) { fprintf(stderr, "hipFuncSetAttribute failed\n"); grid = -1; return; }
        if (hipOccupancyMaxActiveBlocksPerMultiprocessor(&per_cu, (const void*)fwd_kernel, 512, LDS_BYTES) != hipSuccess || per_cu < 1) { fprintf(stderr, "occupancy query: %d\n", per_cu); per_cu = 1; }
        (void)hipGetLastError();
        grid = cus * 1;
        fprintf(stderr, "kernel_launch: grid %d (cus %d, per_cu %d) ws %zu\n", grid, cus, per_cu, ws_size);
    }
    if (grid < 0) return;
    Args a{};
    for (int i = 0; i < 24; ++i) a.in[i] = (const float*)d_in[i];
    a.out = (float*)d_out; a.ws = (unsigned char*)d_ws;
#if MK_PER_PHASE
    for (int p = 0; p < NPHASE; ++p) { a.ph_lo = p; a.ph_hi = p + 1; hipLaunchKernelGGL(fwd_kernel, dim3(grid), dim3(512), LDS_BYTES, stream, a); }
#else
    void* args[] = {&a};
    (void)hipMemsetAsync(d_ws, 0, 65536, stream);
#if DUP_PHASE >= 0
    a.ph_lo = 0; a.ph_hi = DUP_PHASE + 1; a.li = 1;
    (void)hipLaunchCooperativeKernel((const void*)fwd_kernel, dim3(grid), dim3(512), args, LDS_BYTES, stream);
    a.ph_lo = DUP_PHASE; a.ph_hi = NPHASE; a.li = 0;
#else
    a.ph_lo = 0; a.ph_hi = NPHASE;
#endif
    hipError_t e = hipLaunchCooperativeKernel((const void*)fwd_kernel, dim3(grid), dim3(512), args, LDS_BYTES, stream);
    if (e != hipSuccess) fprintf(stderr, "cooperative launch failed: %s (grid %d)\n", hipGetErrorString(e), grid);
#endif
}
```

```cpp
#include <hip/hip_runtime.h>
#include <hip/hip_cooperative_groups.h>
#include <cstdio>
#include <cstdint>
namespace cg = cooperative_groups;
namespace pg8 {
#define PG8_LAS __attribute__((address_space(3)))
typedef unsigned short bf16_t;
typedef short bf16x8 __attribute__((ext_vector_type(8)));
typedef float f32x4 __attribute__((ext_vector_type(4)));
typedef unsigned u32x4 __attribute__((ext_vector_type(4)));
constexpr int BM = 256, BK = 64, HALF = 128, HTB = HALF * BK * 2  , STAGE_BYTES = 8 * HTB, NXCD = 8, WGM = 8;

__host__ __device__ __forceinline__ int lds_byte(int r, int c) { const int st = (r >> 4) * 2 + (c >> 5), rr = r & 15, cc = c & 31, ob = rr * 64 + cc * 2; return st * 1024 + (ob ^ (((ob >> 9) & 1) << 5)); }
__host__ __device__ __forceinline__ void stage_rc(int b, int& R, int& C) { const int st = b / 1024, sb = b % 1024, swz = sb ^ (((sb >> 9) & 1) << 5); R = (st >> 1) * 16 + swz / 64; C = (st & 1) * 32 + (swz % 64) / 2; }
__host__ __device__ __forceinline__ int perm32(int rho) { const int n = rho >> 4, i = rho & 15; return 8 * (i >> 2) + 4 * n + (i & 3); }

struct Unit { int pm, pn; };
struct Gemm { const bf16_t* A; const bf16_t* Bt; int M, N, K; };

struct StaticOrder {
    int nM, nN, nwg, G, c;
    __host__ __device__ void init(int M, int N, int G_, int c_) { nM = M / BM; nN = N / BM; nwg = nM * nN; G = G_; c = c_; }
    __host__ __device__ bool next(int i, Unit& u) const {
        const long L = (long)i * G + c; if (L >= nwg) return false;
        int wgid = (int)L; { const int q = nwg / NXCD, r = nwg % NXCD, xcd = wgid % NXCD, off = wgid / NXCD; wgid = (xcd < r ? xcd * (q + 1) : r * (q + 1) + (xcd - r) * q) + off; }
        const int nig = WGM * nN, gid = wgid / nig, fm = gid * WGM, gsz = (nM - fm) < WGM ? (nM - fm) : WGM;
        u.pm = fm + ((wgid % nig) % gsz); u.pn = (wgid % nig) / gsz; return true;
    }
    __device__ __forceinline__ void a_ready(const Unit&) const {}
    __device__ __forceinline__ void done(const Unit&) const {}
};

__device__ __forceinline__ unsigned cvt_pk_bf16(float lo, float hi) { unsigned r; asm volatile("v_cvt_pk_bf16_f32 %0, %1, %2" : "=v"(r) : "v"(lo), "v"(hi)); return r; }
typedef float f32x2 __attribute__((ext_vector_type(2)));
__device__ __forceinline__ f32x2 gelu_pk(f32x2 v) {
    const f32x2 av = __builtin_elementwise_abs(v), d = av * 0.2316418882f + 1.0f;
    f32x2 t; t.x = __builtin_amdgcn_rcpf(d.x); t.y = __builtin_amdgcn_rcpf(d.y);
    f32x2 q = t * 0.5307027145f + (-0.7265760135f); q = q * t + 0.7107068705f; q = q * t + (-0.142248368f); q = q * t + 0.127414796f; q = q * t;
    const f32x2 s = (v * v) * (-0.72134752044f);
    f32x2 e; e.x = __builtin_amdgcn_exp2f(s.x); e.y = __builtin_amdgcn_exp2f(s.y);
    const f32x2 m = v * (q * e), r = v - m;
    f32x2 o; o.x = v.x < 0.f ? m.x : r.x; o.y = v.y < 0.f ? m.y : r.y; return o;
}

template <int ACT  > struct EpiBf16 {
    static constexpr bool PERM = true, AFTER_DRAIN = false; static_assert(ACT == 0 || ACT == 1, "EpiBf16: ACT is 0 (none) or 1 (gelu_pk)");
    bf16_t* O; int ldc; const float* bias; int split_cols; size_t split_stride; float scale0;
    __device__ __forceinline__ void operator()(const f32x4 (&acc)[2][2][4][2], const Unit& u, int wr, int wc, int fr, int fq) const {
        const int row0 = u.pm * BM + wr * 64 + fr; int colt = u.pn * BM; bf16_t* base = O;
        float sc = 1.f; if (split_cols) { const int t = colt / split_cols; base += (size_t)t * split_stride; colt -= t * split_cols; if (t == 0) sc = scale0; }
        const int col0 = colt + wc * 32 + 8 * fq, bcol0 = u.pn * BM + wc * 32 + 8 * fq;
        f32x4 bv[2][2];
#pragma unroll
        for (int bj = 0; bj < 2; ++bj)
#pragma unroll
            for (int n = 0; n < 2; ++n) bv[bj][n] = bias ? *(const f32x4*)(bias + bcol0 + bj * HALF + 4 * n) : (f32x4){0.f, 0.f, 0.f, 0.f};
#pragma unroll
        for (int ai = 0; ai < 2; ++ai)
#pragma unroll
            for (int m = 0; m < 4; ++m) { bf16_t* rowp = base + (size_t)(row0 + ai * HALF + m * 16) * ldc + col0;
#pragma unroll
                for (int bj = 0; bj < 2; ++bj) { f32x4 v0 = acc[ai][bj][m][0] + bv[bj][0], v1 = acc[ai][bj][m][1] + bv[bj][1];
                    if (ACT == 1) { f32x2 a = gelu_pk((f32x2){v0[0], v0[1]}), b = gelu_pk((f32x2){v0[2], v0[3]}), c = gelu_pk((f32x2){v1[0], v1[1]}), d = gelu_pk((f32x2){v1[2], v1[3]});
                        v0 = (f32x4){a.x, a.y, b.x, b.y}; v1 = (f32x4){c.x, c.y, d.x, d.y}; }
                    v0 = v0 * sc; v1 = v1 * sc; u32x4 w; w.x = cvt_pk_bf16(v0[0], v0[1]); w.y = cvt_pk_bf16(v0[2], v0[3]); w.z = cvt_pk_bf16(v1[0], v1[1]); w.w = cvt_pk_bf16(v1[2], v1[3]);
                    *(u32x4*)(rowp + bj * HALF) = w; } }
    }
};
template <class Epi, class Sched, bool ALIGN_EPI = false, bool SP2 = false>
__device__ __forceinline__ void gemm_phase(PG8_LAS unsigned char* lds, const Gemm g, const Sched& S, const Epi& E) {
    const int tid = threadIdx.x, wid = __builtin_amdgcn_readfirstlane(tid >> 6), lane = tid & 63, wr = wid >> 2, wc = wid & 3, fr = lane & 15, fq = lane >> 4;
    const int K = g.K, nt = K / BK;
    unsigned voffA[2], voffB[2];
#pragma unroll
    for (int i = 0; i < 2; ++i) { int R, C; stage_rc(tid * 16 + i * 8192, R, C); const int Rb = Epi::PERM ? ((R & ~31) + perm32(R & 31)) : R;
        voffA[i] = (unsigned)(R * K + C) * 2u; voffB[i] = (unsigned)(Rb * K + C) * 2u; }
    const size_t kstep = (size_t)(BK * 2);
    const size_t hstep = (size_t)HALF * K * 2;
    const size_t tstep = 2 * hstep;
    const unsigned ldsw = (unsigned)wid * 1024u;
    const int aoff = lds_byte(wr * 64 + fr, fq * 8), boff = lds_byte(wc * 32 + fr, fq * 8);
#define PG8_SA(b, h) (((b) * 2 + (h)) * HTB)
#define PG8_SB(b, h) ((4 + (b) * 2 + (h)) * HTB)
#define PG8_STAGE(bufoff, gbase, voff) do { _Pragma("unroll") for (int _i = 0; _i < 2; ++_i) \
        __builtin_amdgcn_global_load_lds((const unsigned*)((const char*)(gbase) + (voff)[_i]), (PG8_LAS unsigned*)(lds + (bufoff) + ldsw + _i * 8192), 16, 0, 0); } while (0)
#define PG8_LDA(dst, b, h) do { _Pragma("unroll") for (int m = 0; m < 4; ++m) _Pragma("unroll") for (int k = 0; k < 2; ++k) dst[m][k] = *(const PG8_LAS bf16x8*)(lds + PG8_SA(b, h) + aoff + m * 2048 + k * 1024); } while (0)
#define PG8_LDB(dst, b, h) do { _Pragma("unroll") for (int n = 0; n < 2; ++n) _Pragma("unroll") for (int k = 0; k < 2; ++k) dst[n][k] = *(const PG8_LAS bf16x8*)(lds + PG8_SB(b, h) + boff + n * 2048 + k * 1024); } while (0)
#define PG8_MMA(ai, bj, At, Bt) do { __builtin_amdgcn_s_setprio(1); _Pragma("unroll") for (int m = 0; m < 4; ++m) _Pragma("unroll") for (int n = 0; n < 2; ++n) _Pragma("unroll") for (int k = 0; k < 2; ++k) \
        acc[ai][bj][m][n] = __builtin_amdgcn_mfma_f32_16x16x32_bf16(Bt[n][k], At[m][k], acc[ai][bj][m][n], 0, 0, 0); __builtin_amdgcn_s_setprio(0); } while (0)
#define PG8_WAIT_V(n) asm volatile("s_waitcnt vmcnt(" #n ")" ::: "memory")
#define PG8_WAIT_L(n) asm volatile("s_waitcnt lgkmcnt(" #n ")" ::: "memory")
#define PG8_BAR __builtin_amdgcn_s_barrier()
#define PG8_SCHED __builtin_amdgcn_sched_barrier(0)
    Unit cur, nxt; int ui = 0;
    if (!S.next(0, cur)) return;
    f32x4 acc[2][2][4][2];
#pragma unroll
    for (int a = 0; a < 2; ++a)
#pragma unroll
        for (int b = 0; b < 2; ++b)
#pragma unroll
            for (int m = 0; m < 4; ++m)
#pragma unroll
                for (int n = 0; n < 2; ++n) acc[a][b][m][n] = (f32x4){0.f, 0.f, 0.f, 0.f};
    bf16x8 At[4][2], B0[2][2], B1[2][2];
    const char* cA = (const char*)g.A + (size_t)cur.pm * tstep; const char* cB = (const char*)g.Bt + (size_t)cur.pn * tstep;
    S.a_ready(cur);
    if constexpr (SP2) {
        PG8_STAGE(PG8_SB(0, 0), cB, voffB); PG8_STAGE(PG8_SB(0, 1), cB + hstep, voffB); PG8_STAGE(PG8_SA(0, 0), cA, voffA); PG8_STAGE(PG8_SA(0, 1), cA + hstep, voffA);
        if (wr == 1) PG8_BAR;
        PG8_WAIT_V(2); PG8_BAR;
        PG8_STAGE(PG8_SB(1, 0), cB + kstep, voffB); PG8_STAGE(PG8_SA(1, 0), cA + kstep, voffA); PG8_STAGE(PG8_SB(1, 1), cB + hstep + kstep, voffB);
        PG8_WAIT_V(6); PG8_BAR;
    } else {
        PG8_STAGE(PG8_SB(0, 0), cB, voffB); PG8_STAGE(PG8_SA(0, 0), cA, voffA); PG8_STAGE(PG8_SB(0, 1), cB + hstep, voffB); PG8_STAGE(PG8_SA(0, 1), cA + hstep, voffA);
        if (wr == 1) PG8_BAR;
        PG8_WAIT_V(4); PG8_BAR;
        PG8_STAGE(PG8_SB(1, 0), cB + kstep, voffB); PG8_STAGE(PG8_SA(1, 0), cA + kstep, voffA); PG8_STAGE(PG8_SB(1, 1), cB + hstep + kstep, voffB);
        PG8_WAIT_V(6); PG8_BAR;
    }
    for (;;) {
        const bool has_next = S.next(ui + 1, nxt);
        const char* nA = has_next ? (const char*)g.A + (size_t)nxt.pm * tstep : cA; const char* nB = has_next ? (const char*)g.Bt + (size_t)nxt.pn * tstep : cB;
        for (int t = 0; t < nt; t += 2) {
            const bool last = (t == nt - 2);
            const char* a1 = cA + (size_t)(t + 1) * kstep;
            const char* a2 = last ? nA : cA + (size_t)(t + 2) * kstep; const char* b2 = last ? nB : cB + (size_t)(t + 2) * kstep;
            const char* a3 = a2 + kstep; const char* b3 = b2 + kstep;
            if (last && has_next) S.a_ready(nxt);
            if constexpr (SP2) {
            PG8_LDB(B0, 0, 0); PG8_LDB(B1, 0, 1); PG8_SCHED; PG8_LDA(At, 0, 0); PG8_STAGE(PG8_SA(1, 1), a1 + hstep, voffA);
            PG8_WAIT_V(8); PG8_WAIT_L(0); PG8_BAR; PG8_MMA(0, 0, At, B0); PG8_MMA(0, 1, At, B1); PG8_BAR; PG8_SCHED;
            PG8_LDA(At, 0, 1); PG8_STAGE(PG8_SB(0, 0), b2, voffB); PG8_STAGE(PG8_SB(0, 1), b2 + hstep, voffB); PG8_STAGE(PG8_SA(0, 0), a2, voffA);
            PG8_WAIT_V(8); PG8_WAIT_L(0); PG8_BAR; PG8_MMA(1, 0, At, B0); PG8_MMA(1, 1, At, B1); PG8_BAR; PG8_SCHED;
            PG8_LDB(B0, 1, 0); PG8_LDB(B1, 1, 1); PG8_SCHED; PG8_LDA(At, 1, 0); PG8_STAGE(PG8_SA(0, 1), a2 + hstep, voffA);
            PG8_WAIT_V(8); PG8_WAIT_L(0); PG8_BAR; PG8_MMA(0, 0, At, B0); PG8_MMA(0, 1, At, B1); PG8_BAR; PG8_SCHED;
            PG8_LDA(At, 1, 1); PG8_STAGE(PG8_SB(1, 0), b3, voffB); PG8_STAGE(PG8_SB(1, 1), b3 + hstep, voffB); PG8_STAGE(PG8_SA(1, 0), a3, voffA);
            PG8_WAIT_V(8); PG8_WAIT_L(0); PG8_BAR; PG8_MMA(1, 0, At, B0); PG8_MMA(1, 1, At, B1); PG8_BAR; PG8_SCHED;
            } else {
            PG8_LDB(B0, 0, 0); PG8_SCHED; PG8_LDA(At, 0, 0); PG8_STAGE(PG8_SA(1, 1), a1 + hstep, voffA);
            PG8_WAIT_L(8); PG8_BAR; PG8_WAIT_L(0); PG8_MMA(0, 0, At, B0); PG8_BAR; PG8_SCHED;
            PG8_LDB(B1, 0, 1); PG8_STAGE(PG8_SB(0, 0), b2, voffB);
            PG8_BAR; PG8_WAIT_L(0); PG8_MMA(0, 1, At, B1); PG8_BAR;
            PG8_LDA(At, 0, 1); PG8_STAGE(PG8_SA(0, 0), a2, voffA);
            PG8_BAR; PG8_WAIT_L(0); PG8_MMA(1, 0, At, B0); PG8_BAR; PG8_SCHED;
            PG8_STAGE(PG8_SB(0, 1), b2 + hstep, voffB);
            PG8_WAIT_V(6); PG8_BAR; PG8_MMA(1, 1, At, B1); PG8_BAR;
            PG8_LDB(B0, 1, 0); PG8_SCHED; PG8_LDA(At, 1, 0); PG8_STAGE(PG8_SA(0, 1), a2 + hstep, voffA);
            PG8_WAIT_L(8); PG8_BAR; PG8_WAIT_L(0); PG8_MMA(0, 0, At, B0); PG8_BAR; PG8_SCHED;
            PG8_LDB(B1, 1, 1); PG8_STAGE(PG8_SB(1, 0), b3, voffB);
            PG8_BAR; PG8_WAIT_L(0); PG8_MMA(0, 1, At, B1); PG8_BAR;
            PG8_LDA(At, 1, 1); PG8_STAGE(PG8_SA(1, 0), a3, voffA);
            PG8_BAR; PG8_WAIT_L(0); PG8_MMA(1, 0, At, B0); PG8_BAR; PG8_SCHED;
            PG8_STAGE(PG8_SB(1, 1), b3 + hstep, voffB);
            PG8_WAIT_V(6); PG8_BAR; PG8_MMA(1, 1, At, B1); PG8_BAR;
            }
        }
        if constexpr (ALIGN_EPI) { if (wr == 0) PG8_BAR; }
        if constexpr (!Epi::AFTER_DRAIN) { E(acc, cur, wr, wc, fr, fq); S.done(cur); }
        if (!has_next) break;
#pragma unroll
        for (int a = 0; a < 2; ++a)
#pragma unroll
            for (int b = 0; b < 2; ++b)
#pragma unroll
                for (int m = 0; m < 4; ++m)
#pragma unroll
                    for (int n = 0; n < 2; ++n) acc[a][b][m][n] = (f32x4){0.f, 0.f, 0.f, 0.f};
        cur = nxt; cA = nA; cB = nB; ++ui;
        if constexpr (ALIGN_EPI) { if (wr == 1) PG8_BAR; }
    }
    PG8_WAIT_V(0);
    if constexpr (!ALIGN_EPI) { if (wr == 0) PG8_BAR; }
    PG8_BAR;
    if constexpr (Epi::AFTER_DRAIN) { E.fused(acc, cur, wr, wc, fr, fq, lds, wid, lane); S.done(cur); }
#undef PG8_SA
#undef PG8_SB
#undef PG8_STAGE
#undef PG8_LDA
#undef PG8_LDB
#undef PG8_MMA
#undef PG8_WAIT_V
#undef PG8_WAIT_L
#undef PG8_BAR
#undef PG8_SCHED
}
}
namespace pg8 {
struct EpiAxpyF32 {
    static constexpr bool PERM = false, AFTER_DRAIN = false;
    const float* base; float* out; int ldc; float alpha;
    __device__ __forceinline__ void operator()(const f32x4 (&acc)[2][2][4][2], const Unit& u, int wr, int wc, int fr, int fq) const {
        const int row0 = u.pm * BM + wr * 64 + fr, col0 = u.pn * BM + wc * 32 + 4 * fq;
#pragma unroll
        for (int ai = 0; ai < 2; ++ai)
#pragma unroll
            for (int m = 0; m < 4; ++m) { const size_t ro = (size_t)(row0 + ai * HALF + m * 16) * ldc + col0;
#pragma unroll
                for (int bj = 0; bj < 2; ++bj)
#pragma unroll
                    for (int n = 0; n < 2; ++n) { const size_t off = ro + bj * HALF + n * 16; const f32x4 b = *(const f32x4*)(base + off); *(f32x4*)(out + off) = b * alpha + acc[ai][bj][m][n]; } }
    }
};
}

#define LAS __attribute__((address_space(3)))
typedef unsigned short bf16_t;
typedef short bf16x8 __attribute__((ext_vector_type(8)));
typedef short s16x4 __attribute__((ext_vector_type(4)));
typedef float f32x2 __attribute__((ext_vector_type(2)));
typedef float f32x4 __attribute__((ext_vector_type(4)));
typedef float f32x16 __attribute__((ext_vector_type(16)));
typedef unsigned u32x2 __attribute__((ext_vector_type(2)));
typedef unsigned u32x4 __attribute__((ext_vector_type(4)));
typedef __bf16 bf16x2v __attribute__((ext_vector_type(2)));

constexpr int T_TOK = 49152, DM = 1024, NPROJ = 3072, DFF = 2816, NFF = 5632, HYW = 512;
constexpr int L_P = 2048, L_S = 4096, TOK_P = 32768;
constexpr int CHUNK = 16384, NCHUNK = 3;
constexpr float ALPHA_F = 1.189207115002721f;
constexpr float LN_EPS_F = 1e-5f, RMS_EPS_F = 1e-6f;
constexpr size_t MiB = 1u << 20;
constexpr size_t WS_WIN = 2 * MiB, WS_WOUT = 8 * MiB, WS_WF1 = 10 * MiB, WS_WF2 = 22 * MiB;
constexpr size_t WS_FILT_P = 28 * MiB, WS_FILT_S = 36 * MiB;
constexpr size_t WS_XB = 52 * MiB;
constexpr size_t WS_PROJ = 148 * MiB;
constexpr size_t WS_X1B = 148 * MiB, WS_U = 244 * MiB, WS_HID = 420 * MiB;
constexpr size_t WS_NEED = 508 * MiB;
constexpr int LDS_BYTES = 147456;

__device__ __forceinline__ unsigned pk2(float a, float b) { f32x2 v = {a, b}; bf16x2v r = __builtin_convertvector(v, bf16x2v); return __builtin_bit_cast(unsigned, r); }
__device__ __forceinline__ float bf2f(unsigned short h) { return __builtin_bit_cast(float, (unsigned)h << 16); }
__device__ __forceinline__ float bflo(unsigned w) { return __builtin_bit_cast(float, w << 16); }
__device__ __forceinline__ float bfhi(unsigned w) { return __builtin_bit_cast(float, w & 0xffff0000u); }
#define MFMA32(a, b, c) __builtin_amdgcn_mfma_f32_32x32x16_bf16((a), (b), (c), 0, 0, 0)
#define LDS_WAIT() asm volatile("s_waitcnt lgkmcnt(0)" ::: "memory")
__device__ __forceinline__ int crow(int reg, int h) { return (reg & 3) + 8 * (reg >> 2) + 4 * h; }
__device__ __forceinline__ float sin_turns(float tr) { tr = tr - floorf(tr); return __builtin_amdgcn_sinf(tr); }
__device__ __forceinline__ float fast_sin(float x) { return sin_turns(x * 0.15915494309189535f); }
__device__ __forceinline__ float wave_sum(float v) {
#pragma unroll
    for (int o = 1; o < 64; o <<= 1) v += __shfl_xor(v, o);
    return v;
}

#define XB_TMO      128
#define XB_XCNT(j)  (256  + 64 * (j))
#define XB_XSUB(j)  (1280 + 64 * (j))
#define XB_XGEN(j)  (2304 + 64 * (j))
#define XB_TOP      3328
#define XB_TOPGEN   3392
#define XCD_BAR_WORDS 3456
#define XB_SPIN_CAP (1u << 18)

__device__ __forceinline__ unsigned xb_ld(unsigned* p)              { return __hip_atomic_load(p, __ATOMIC_RELAXED, __HIP_MEMORY_SCOPE_AGENT); }
__device__ __forceinline__ unsigned xb_add(unsigned* p, unsigned v) { return __hip_atomic_fetch_add(p, v, __ATOMIC_RELAXED, __HIP_MEMORY_SCOPE_AGENT); }
__device__ __forceinline__ unsigned xb_xcc_id() { return (unsigned)__builtin_amdgcn_s_getreg((3 << 11) | 20) & 0xFu; }
#define XB_SPIN(cond, bar) do { unsigned _sp = 0; while (cond) { __builtin_amdgcn_s_sleep(1); \
    if ((++_sp & 255u) == 0u) { if (xb_ld(&(bar)[XB_TMO])) break; if (_sp > XB_SPIN_CAP) { atomicAdd(&(bar)[XB_TMO], 1u); break; } } } } while (0)

struct XcdBarrier {
    unsigned* bar; unsigned x;
    volatile LAS unsigned* st;
};

__device__ __forceinline__ XcdBarrier xcd_barrier_post(unsigned* bar, volatile LAS unsigned* st) {
    XcdBarrier b; b.bar = bar; b.x = xb_xcc_id(); b.st = st;
    if (threadIdx.x == 0) (void)xb_add(&bar[XB_XCNT(b.x)], 1u);
    return b;
}
__device__ __forceinline__ void xcd_barrier_complete(unsigned* bar, unsigned x, unsigned& nloc, unsigned& nx) {
    const unsigned G = gridDim.x * gridDim.y * gridDim.z;
    unsigned sum, cnt, mine, sp = 0u;
    for (;;) {
        sum = 0u; cnt = 0u; mine = 0u;
#pragma unroll
        for (unsigned j = 0; j < 16; ++j) { const unsigned c = xb_ld(&bar[XB_XCNT(j)]); sum += c; cnt += (c > 0u) ? 1u : 0u; mine = (j == x) ? c : mine; }
        if (sum == G) break;
        __builtin_amdgcn_s_sleep(1);
        if ((++sp & 255u) == 0u) { if (xb_ld(&bar[XB_TMO])) break; if (sp > XB_SPIN_CAP) { atomicAdd(&bar[XB_TMO], 1u); break; } }
    }
    nloc = mine > 0u ? mine : 1u; nx = cnt > 0u ? cnt : 1u;
}

__device__ __forceinline__ void xcd_barrier(const XcdBarrier& b) {
    asm volatile("s_waitcnt vmcnt(0)" ::: "memory");
    __syncthreads();
    if (threadIdx.x == 0) {
        unsigned* bar = b.bar;
        __builtin_amdgcn_s_waitcnt(0);
        unsigned nloc = b.st[0], nx = b.st[1];
        if (nloc == 0u) { xcd_barrier_complete(bar, b.x, nloc, nx); b.st[0] = nloc; b.st[1] = nx; }
        const unsigned old = xb_add(&bar[XB_XSUB(b.x)], 1u);
        const unsigned gen = old / nloc;
        if (old + 1u == (gen + 1u) * nloc) {
            __builtin_amdgcn_fence(__ATOMIC_RELEASE, "agent");
            asm volatile("s_waitcnt vmcnt(0)" ::: "memory");
            const unsigned og = xb_add(&bar[XB_TOP], 1u);
            const unsigned tg = og / nx;
            if (og + 1u == (tg + 1u) * nx) xb_add(&bar[XB_TOPGEN], 1u);
            else XB_SPIN(xb_ld(&bar[XB_TOPGEN]) == tg, bar);
            __builtin_amdgcn_fence(__ATOMIC_ACQUIRE, "agent");
            xb_add(&bar[XB_XGEN(b.x)], 1u);
            asm volatile("s_waitcnt vmcnt(0)" ::: "memory");
        } else {
            XB_SPIN(xb_ld(&bar[XB_XGEN(b.x)]) == gen, bar);
            __builtin_amdgcn_fence(__ATOMIC_ACQUIRE, "agent");
            asm volatile("s_waitcnt vmcnt(0)" ::: "memory");
        }
    }
    __syncthreads();
}

struct Args { const float* in[24]; float* out; unsigned char* ws; int ph_lo, ph_hi, li, pad; };
enum { I_XP = 0, I_XS, I_WIN, I_SW, I_SB, I_RPB, I_FW1, I_FB1, I_FFREQ, I_FWI, I_FBI, I_FW3, I_FBIAS, I_GA, I_GH, I_WOUT, I_LN1G, I_LN1B, I_FFW1, I_FFCW, I_FFCB, I_FFW2, I_LN2G, I_LN2B };

__device__ __forceinline__ void p0_transpose_item(const float* W, int K, int N, bf16_t* WT, LAS float* scr, int item, int lane) {
    const int nblk = N / 32, kb = item / nblk, nb = item % nblk, k0 = 64 * kb, n0 = 32 * nb;
#pragma unroll 8
    for (int i = 0; i < 32; ++i) { const int kk = 2 * i + (lane >> 5); scr[kk * 33 + (lane & 31)] = W[(size_t)(k0 + kk) * N + n0 + (lane & 31)]; }
    LDS_WAIT();
    const int c = lane & 7;
#pragma unroll
    for (int j = 0; j < 4; ++j) { const int n = (lane >> 3) + 8 * j; const LAS float* s = scr + (8 * c) * 33 + n;
        u32x4 o; o.x = pk2(s[0 * 33], s[1 * 33]); o.y = pk2(s[2 * 33], s[3 * 33]); o.z = pk2(s[4 * 33], s[5 * 33]); o.w = pk2(s[6 * 33], s[7 * 33]);
        *(u32x4*)(WT + (size_t)(n0 + n) * K + k0 + 8 * c) = o; }
    LDS_WAIT();
}

template <int L>
__device__ __forceinline__ void filter_unit(const Args& A, bf16_t* Rg, LAS unsigned char* lds, int unit, int tid) {
    constexpr int NP = 33;
    LAS float* Z = (LAS float*)lds;
    LAS float* H1 = Z + NP * 36;
    LAS float* H2 = H1 + NP * 65;
    const float* w1 = A.in[I_FW1]; const float* b1 = A.in[I_FB1]; const float* fq = A.in[I_FFREQ];
    const float* wi = A.in[I_FWI]; const float* bi = A.in[I_FBI]; const float* w3 = A.in[I_FW3];
    const int t0 = unit * 32;
    for (int idx = tid; idx < NP * 33; idx += 512) {
        const int p = idx / 33, f = idx % 33, t = min(t0 + p, L - 1); float val;
        if (f == 0) val = (float)t / (float)(L - 1);
        else { const int k = (f - 1) & 15; const float fr = 1e-4f + (float)k * ((15.0f - 1e-4f) / 15.0f); const float tr = ((float)t / (float)L) * fr; val = (f <= 16) ? sin_turns(tr + 0.25f) : -sin_turns(tr); }
        Z[p * 36 + f] = val;
    }
    __syncthreads();
    const int pg = tid >> 6, j_ = tid & 63; const float fqj = fq[j_];
    { float a0 = b1[j_], a1 = a0, a2 = a0, a3 = a0, a4 = a0;
#pragma unroll 11
      for (int f = 0; f < 33; ++f) { const float w = w1[f * 64 + j_]; a0 += Z[pg * 36 + f] * w; a1 += Z[(pg + 8) * 36 + f] * w; a2 += Z[(pg + 16) * 36 + f] * w; a3 += Z[(pg + 24) * 36 + f] * w; a4 += Z[32 * 36 + f] * w; }
      H1[pg * 65 + j_] = fast_sin(fqj * a0); H1[(pg + 8) * 65 + j_] = fast_sin(fqj * a1); H1[(pg + 16) * 65 + j_] = fast_sin(fqj * a2); H1[(pg + 24) * 65 + j_] = fast_sin(fqj * a3); if (pg == 0) H1[32 * 65 + j_] = fast_sin(fqj * a4); }
    __syncthreads();
    { float a0 = bi[j_], a1 = a0, a2 = a0, a3 = a0, a4 = a0;
#pragma unroll 16
      for (int f = 0; f < 64; ++f) { const float w = wi[f * 64 + j_]; a0 += H1[pg * 65 + f] * w; a1 += H1[(pg + 8) * 65 + f] * w; a2 += H1[(pg + 16) * 65 + f] * w; a3 += H1[(pg + 24) * 65 + f] * w; a4 += H1[32 * 65 + f] * w; }
      H2[pg * 65 + j_] = fast_sin(fqj * a0); H2[(pg + 8) * 65 + j_] = fast_sin(fqj * a1); H2[(pg + 16) * 65 + j_] = fast_sin(fqj * a2); H2[(pg + 24) * 65 + j_] = fast_sin(fqj * a3); if (pg == 0) H2[32 * 65 + j_] = fast_sin(fqj * a4); }
    __syncthreads();
    { float a0 = bi[64 + j_], a1 = a0, a2 = a0, a3 = a0, a4 = a0;
#pragma unroll 16
      for (int f = 0; f < 64; ++f) { const float w = wi[4096 + f * 64 + j_]; a0 += H2[pg * 65 + f] * w; a1 += H2[(pg + 8) * 65 + f] * w; a2 += H2[(pg + 16) * 65 + f] * w; a3 += H2[(pg + 24) * 65 + f] * w; a4 += H2[32 * 65 + f] * w; }
      H1[pg * 65 + j_] = fast_sin(fqj * a0); H1[(pg + 8) * 65 + j_] = fast_sin(fqj * a1); H1[(pg + 16) * 65 + j_] = fast_sin(fqj * a2); H1[(pg + 24) * 65 + j_] = fast_sin(fqj * a3); if (pg == 0) H1[32 * 65 + j_] = fast_sin(fqj * a4); }
    __syncthreads();
    const int c = tid;
    float af[NP], ab[32];
#pragma unroll
    for (int p = 0; p < NP; ++p) af[p] = 0.f;
#pragma unroll
    for (int p = 0; p < 32; ++p) ab[p] = 0.f;
#pragma unroll 4
    for (int k = 0; k < 64; ++k) { const float wf = w3[k * 1024 + c], wb = w3[k * 1024 + 512 + c];
#pragma unroll
        for (int p = 0; p < NP; ++p) { const float h = H1[p * 65 + k]; af[p] += h * wf; if (p < 32) ab[p] += h * wb; } }
    const float MIN_DECAY = -3.0701134573253945f, MAX_DECAY = -15.350567286626973f;
    const float delta = fabsf(MIN_DECAY + (float)c * ((MAX_DECAY - MIN_DECAY) / 511.0f));
#pragma unroll
    for (int p = 0; p < NP; ++p) { const float tl = (float)(t0 + p) / (float)(L - 1); const float dec = __expf(-tl * delta); af[p] *= dec; if (p < 32) ab[p] *= dec; }
    if (t0 == 0) ab[0] = af[0];
    if (t0 + 32 == L) af[32] = 0.f;
    bf16_t* R = Rg + (size_t)c * (2 * L);
#pragma unroll
    for (int q = 0; q < 4; ++q) { u32x4 w;
        w.x = pk2(af[32 - 8 * q], af[31 - 8 * q]); w.y = pk2(af[30 - 8 * q], af[29 - 8 * q]); w.z = pk2(af[28 - 8 * q], af[27 - 8 * q]); w.w = pk2(af[26 - 8 * q], af[25 - 8 * q]);
        *(u32x4*)(R + L - t0 - 32 + 8 * q) = w;
        u32x4 v; v.x = pk2(ab[8 * q], ab[8 * q + 1]); v.y = pk2(ab[8 * q + 2], ab[8 * q + 3]); v.z = pk2(ab[8 * q + 4], ab[8 * q + 5]); v.w = pk2(ab[8 * q + 6], ab[8 * q + 7]);
        *(u32x4*)(R + L + t0 + 8 * q) = v; }
    __syncthreads();
}

__device__ __forceinline__ void p0_prologue(const Args& A, LAS unsigned char* lds, int tid, int wave, int lane) {
    unsigned char* ws = A.ws;
    const int bx = blockIdx.x, G = gridDim.x;
#ifndef F_REPS
#define F_REPS 1
#define W_REPS 1
#define X_REPS 1
#define T_REPS 1
#define CG_REPS 1
#endif
    for (int rep_ = 0; rep_ < F_REPS; ++rep_) for (int u = bx; u < 192; u += G) { if (u < 64) filter_unit<L_P>(A, (bf16_t*)(ws + WS_FILT_P), lds, u, tid); else filter_unit<L_S>(A, (bf16_t*)(ws + WS_FILT_S), lds, u - 64, tid); }
    __syncthreads();
    LAS float* scr = (LAS float*)(lds + wave * 16384);
    const int gw = bx * 8 + wave, NGW = G * 8;
    constexpr int I1 = 16 * 96, I2 = 16 * 32, I3 = 16 * 176, I4 = 44 * 32;
    for (int rep_ = 0; rep_ < W_REPS; ++rep_) for (int it = gw; it < I1 + I2 + I3 + I4; it += NGW) {
        int r = it;
        if (r < I1) { p0_transpose_item(A.in[I_WIN], 1024, 3072, (bf16_t*)(ws + WS_WIN), scr, r, lane); continue; } r -= I1;
        if (r < I2) { p0_transpose_item(A.in[I_WOUT], 1024, 1024, (bf16_t*)(ws + WS_WOUT), scr, r, lane); continue; } r -= I2;
        if (r < I3) { p0_transpose_item(A.in[I_FFW1], 1024, 5632, (bf16_t*)(ws + WS_WF1), scr, r, lane); continue; } r -= I3;
        p0_transpose_item(A.in[I_FFW2], 2816, 1024, (bf16_t*)(ws + WS_WF2), scr, r, lane);
    }
    bf16_t* xb = (bf16_t*)(ws + WS_XB);
    for (int rep_ = 0; rep_ < X_REPS; ++rep_) for (int m = gw; m < T_TOK; m += 2 * NGW) {
        const int m2 = m + NGW;
        const float* xr = (m < TOK_P) ? (A.in[I_XP] + (size_t)m * DM) : (A.in[I_XS] + (size_t)(m - TOK_P) * DM);
        const float* xr2 = (m2 < TOK_P) ? (A.in[I_XP] + (size_t)m2 * DM) : (A.in[I_XS] + (size_t)(m2 - TOK_P) * DM);
        const f32x4* x4 = (const f32x4*)xr + lane; u32x2* o = (u32x2*)(xb + (size_t)m * DM) + lane;
        const f32x4* y4 = (const f32x4*)xr2 + lane; u32x2* o2 = (u32x2*)(xb + (size_t)m2 * DM) + lane;
        f32x4 v[4], v2[4];
#pragma unroll
        for (int j = 0; j < 4; ++j) { v[j] = x4[64 * j]; v2[j] = (m2 < T_TOK) ? y4[64 * j] : v[j]; }
#pragma unroll
        for (int j = 0; j < 4; ++j) { u32x2 w; w.x = pk2(v[j].x, v[j].y); w.y = pk2(v[j].z, v[j].w); o[64 * j] = w;
            if (m2 < T_TOK) { u32x2 w2; w2.x = pk2(v2[j].x, v2[j].y); w2.y = pk2(v2[j].z, v2[j].w); o2[64 * j] = w2; } }
    }
}

__device__ __forceinline__ s16x4 tr_read(unsigned lds_addr) { s16x4 r; asm volatile("ds_read_b64_tr_b16 %0, %1\n\ts_waitcnt lgkmcnt(0)" : "=&v"(r) : "v"(lds_addr) : "memory"); return r; }

__device__ constexpr bool att_need(int QT, int kt, int i) { return QT == 0 ? (kt == 0 || i < 4) : (kt == 1 || i >= 12); }
template <int KT, int ST>
__device__ __forceinline__ void att_pv_step(const f32x16 (&s)[2], f32x16 (&o)[2], unsigned abase) {
    u32x4 w;
    w.x = pk2(s[KT][8 * ST + 0], s[KT][8 * ST + 1]); w.y = pk2(s[KT][8 * ST + 2], s[KT][8 * ST + 3]);
    w.z = pk2(s[KT][8 * ST + 4], s[KT][8 * ST + 5]); w.w = pk2(s[KT][8 * ST + 6], s[KT][8 * ST + 7]);
    const bf16x8 pf = __builtin_bit_cast(bf16x8, w);
    s16x4 l0, h0, l1, h1;
    constexpr int OFF = (32 * KT + 16 * ST) * 144;
    asm volatile("ds_read_b64_tr_b16 %0, %4 offset:%5\n\tds_read_b64_tr_b16 %1, %4 offset:%6\n\tds_read_b64_tr_b16 %2, %4 offset:%7\n\tds_read_b64_tr_b16 %3, %4 offset:%8\n\ts_waitcnt lgkmcnt(0)"
                 : "=&v"(l0), "=&v"(h0), "=&v"(l1), "=&v"(h1) : "v"(abase), "i"(OFF), "i"(OFF + 8 * 144), "i"(OFF + 64), "i"(OFF + 64 + 8 * 144) : "memory");
    const bf16x8 v0 = __builtin_shufflevector(l0, h0, 0, 1, 2, 3, 4, 5, 6, 7), v1 = __builtin_shufflevector(l1, h1, 0, 1, 2, 3, 4, 5, 6, 7);
    o[0] = MFMA32(v0, pf, o[0]); o[1] = MFMA32(v1, pf, o[1]);
}
template <int QT>
__device__ __forceinline__ void attn_pass(const bf16_t* proj, const LAS float* bl, LAS unsigned char* vl, int tok0, int seqbase, int r, int r0, int h, int lane, LAS unsigned char* odst, float& ssout) {
    const int rr = lane & 31, hh = lane >> 5;
    bf16x8 qf[4];
#pragma unroll
    for (int ks = 0; ks < 4; ++ks) qf[ks] = *(const bf16x8*)(proj + (size_t)(tok0 + 32 * QT + rr) * NPROJ + 64 * h + 16 * ks + 8 * hh);
    f32x16 o[2];
#pragma unroll
    for (int a = 0; a < 2; ++a)
#pragma unroll
        for (int i = 0; i < 16; ++i) o[a][i] = 0.f;
    float m_run = 0.f, lsum = 0.f;
    const int i16 = lane & 15, tq = i16 >> 2, tp = i16 & 3, blk = (lane >> 4) & 1;
    const unsigned abase = (unsigned)(size_t)vl + (unsigned)((4 * hh + tq) * 144 + 32 * blk + 8 * tp);
    const int qc = 32 * QT + rr, cs = min(max(qc - 8, 0), 48), xm = 4 * hh - cs;
    const LAS float* blane = bl + 64 + 15 + 4 * hh - qc;
    const bf16_t* kbase = proj + (size_t)(seqbase + 64 * r0 + rr) * NPROJ + 512 + 64 * h + 8 * hh;
    const bf16_t* vgbase = proj + (size_t)(seqbase + 64 * r0 + (lane >> 3)) * NPROJ + 1024 + 64 * h + 8 * (lane & 7);
    LAS unsigned char* vst = vl + (lane >> 3) * 144 + 16 * (lane & 7);
    bf16x8 Kc[2][4]; u32x4 Vr[8];
#pragma unroll
    for (int kt = 0; kt < 2; ++kt)
#pragma unroll
        for (int ks = 0; ks < 4; ++ks) Kc[kt][ks] = *(const bf16x8*)(kbase + (size_t)(32 * kt) * NPROJ + 16 * ks);
#pragma unroll
    for (int i = 0; i < 8; ++i) Vr[i] = *(const u32x4*)(vgbase + (size_t)(8 * i) * NPROJ);
#pragma unroll
    for (int i = 0; i < 8; ++i) *(LAS u32x4*)(vst + 8 * i * 144) = Vr[i];
    LDS_WAIT();
#pragma unroll 1
    for (int kr = 0; kr < 8; ++kr) {
        f32x16 s[2];
#pragma unroll
        for (int a = 0; a < 2; ++a)
#pragma unroll
            for (int i = 0; i < 16; ++i) s[a][i] = 0.f;
#pragma unroll
        for (int kt = 0; kt < 2; ++kt)
#pragma unroll
            for (int ks = 0; ks < 4; ++ks) s[kt] = MFMA32(Kc[kt][ks], qf[ks], s[kt]);
        if (kr < 7) {
            const size_t adv = (size_t)(64 * (kr + 1)) * NPROJ;
#pragma unroll
            for (int kt = 0; kt < 2; ++kt)
#pragma unroll
                for (int ks = 0; ks < 4; ++ks) Kc[kt][ks] = *(const bf16x8*)(kbase + adv + (size_t)(32 * kt) * NPROJ + 16 * ks);
#pragma unroll
            for (int i = 0; i < 8; ++i) Vr[i] = *(const u32x4*)(vgbase + adv + (size_t)(8 * i) * NPROJ);
        }
        const int dr = r0 + kr - r + 7; const LAS float* brow = blane + dr * 31;
        const float C1 = 0.125f * 1.4426950408889634f;
        float mx = -1e30f;
#pragma unroll
        for (int kt = 0; kt < 2; ++kt)
#pragma unroll
            for (int i = 0; i < 16; ++i) if (att_need(QT, kt, i)) { const int ce = 32 * kt + (i & 3) + 8 * (i >> 2);
                const bool valid = (unsigned)(xm + ce) < 16u;
                const float bval = brow[ce]; const float sv = s[kt][i] * C1 + bval;
                const float v = valid ? sv : -INFINITY; s[kt][i] = v; mx = fmaxf(mx, v); }
        mx = fmaxf(mx, __shfl_xor(mx, 32));
        if (kr == 0) m_run = mx;
        else if (__any(mx > m_run + 8.0f)) { const float mnew = fmaxf(m_run, mx), alpha = __builtin_amdgcn_exp2f(m_run - mnew); lsum *= alpha; m_run = mnew;
#pragma unroll
            for (int dt = 0; dt < 2; ++dt)
#pragma unroll
                for (int i = 0; i < 16; ++i) o[dt][i] *= alpha; }
#pragma unroll
        for (int kt = 0; kt < 2; ++kt)
#pragma unroll
            for (int i = 0; i < 16; ++i) { if (att_need(QT, kt, i)) { const float p = __builtin_amdgcn_exp2f(s[kt][i] - m_run); s[kt][i] = p; lsum += p; } else s[kt][i] = 0.f; }
        if (QT == 0) { att_pv_step<0, 0>(s, o, abase); att_pv_step<0, 1>(s, o, abase); att_pv_step<1, 0>(s, o, abase); }
        else { att_pv_step<0, 1>(s, o, abase); att_pv_step<1, 0>(s, o, abase); att_pv_step<1, 1>(s, o, abase); }
        if (kr < 7) {
#pragma unroll
            for (int i = 0; i < 8; ++i) *(LAS u32x4*)(vst + 8 * i * 144) = Vr[i];
            LDS_WAIT();
        }
    }
    const float l_run = lsum + __shfl_xor(lsum, 32);
    const float inv = 1.0f / l_run; float ss = 0.f;
#pragma unroll
    for (int dt = 0; dt < 2; ++dt)
#pragma unroll
        for (int g = 0; g < 4; ++g) { const float v0 = o[dt][4 * g] * inv, v1 = o[dt][4 * g + 1] * inv, v2 = o[dt][4 * g + 2] * inv, v3 = o[dt][4 * g + 3] * inv;
            ss += (v0 * v0 + v1 * v1) + (v2 * v2 + v3 * v3); u32x2 w; w.x = pk2(v0, v1); w.y = pk2(v2, v3);
            *(LAS u32x2*)(odst + rr * 144 + 2 * (32 * dt + 8 * g + 4 * hh)) = w; }
    ss += __shfl_xor(ss, 32);
    ssout = ss;
}

__device__ __forceinline__ void attn_unit(const bf16_t* proj, const float* rpb, const float* g_attn, bf16_t* merged, LAS unsigned char* lds, int u, int wave, int lane) {
    const int tok0 = 64 * u; int rows, r, seqbase;
    if (u < 512) { rows = 32; r = u & 31; seqbase = (u >> 5) * 2048; } else { const int v = u - 512; rows = 64; r = v & 63; seqbase = TOK_P + (v >> 6) * 4096; }
    const int r0 = min(max(r - 4, 0), rows - 8);
    const int h = wave, rr = lane & 31, hh = lane >> 5;
    LAS unsigned char* vl = lds + wave * 9216;
    LAS float* bl = (LAS float*)(lds + 73728 + wave * 2432);
    LAS float* ssq = (LAS float*)(lds + 73728 + 8 * 2432);
    for (int i = lane; i < 608; i += 64) { const int j = i - 64; bl[i] = (j >= 0 && j < 465) ? rpb[h * 465 + j] * 1.4426950408889634f : 0.f; }
    LDS_WAIT();
    LAS unsigned char* ost0 = lds + 95232 + wave * 4608;
    float ss0, ss1;
    attn_pass<0>(proj, bl, vl, tok0, seqbase, r, r0, h, lane, ost0, ss0);
    attn_pass<1>(proj, bl, vl, tok0, seqbase, r, r0, h, lane, vl + 32 * 144, ss1);
    if (hh == 0) { ssq[wave * 64 + rr] = ss0; ssq[wave * 64 + 32 + rr] = ss1; }
    __syncthreads();
    float tot = 0.f;
#pragma unroll
    for (int w = 0; w < 8; ++w) tot += ssq[w * 64 + lane];
    const float rs = 1.0f / sqrtf(tot * (1.0f / 512.0f) + RMS_EPS_F);
    const f32x4 g0 = *(const f32x4*)(g_attn + 64 * h + 8 * (lane & 7)), g1 = *(const f32x4*)(g_attn + 64 * h + 8 * (lane & 7) + 4);
#pragma unroll
    for (int i = 0; i < 8; ++i) { const int q = (lane >> 3) + 8 * i; const float rq = __shfl(rs, q);
        const LAS unsigned char* src = (i < 4 ? ost0 + q * 144 : vl + q * 144) + 16 * (lane & 7);
        const u32x4 v = *(const LAS u32x4*)src; u32x4 w;
        w.x = pk2(bflo(v.x) * rq * g0.x, bfhi(v.x) * rq * g0.y); w.y = pk2(bflo(v.y) * rq * g0.z, bfhi(v.y) * rq * g0.w);
        w.z = pk2(bflo(v.z) * rq * g1.x, bfhi(v.z) * rq * g1.y); w.w = pk2(bflo(v.w) * rq * g1.z, bfhi(v.w) * rq * g1.w);
        *(u32x4*)(merged + (size_t)(tok0 + q) * DM + 64 * h + 8 * (lane & 7)) = w; }
    __syncthreads();
}

__device__ __forceinline__ void hyprep_unit(const bf16_t* proj, const float* sw, const float* sb, bf16_t* vT, bf16_t* x0T, LAS unsigned char* lds, int u, int tid) {
    const int tok0 = 64 * u; int L, s_tile, seqbase;
    if (u < 512) { L = 2048; s_tile = (u & 31) * 64; seqbase = (u >> 5) * 2048; } else { const int v = u - 512; L = 4096; s_tile = (v & 63) * 64; seqbase = TOK_P + (v >> 6) * 4096; }
    LAS unsigned* VL = (LAS unsigned*)lds;
    LAS unsigned* XL = VL + 512 * 33;
    const int tslot = tid >> 7, cgp = tid & 127, c = 4 * cgp;
    f32x4 w[3][3], bb[3];
#pragma unroll
    for (int st = 0; st < 3; ++st) {
#pragma unroll
        for (int k = 0; k < 3; ++k) w[st][k] = *(const f32x4*)(sw + k * 1536 + st * 512 + c);
        bb[st] = *(const f32x4*)(sb + st * 512 + c); }
#pragma unroll 1
    for (int half = 0; half < 2; ++half) {
        const int tb = 16 * tslot + 8 * half;
        const int sbeg = s_tile + tb;
        const bf16_t* pbase = proj + (size_t)(tok0 + tb) * NPROJ + 1536 + c;
        u32x2 raw[10][3];
#pragma unroll
        for (int rI = 0; rI < 10; ++rI) { const int sp = sbeg + rI - 1; const bool ok = (sp >= 0) && (sp < L);
#pragma unroll
            for (int st = 0; st < 3; ++st) { u32x2 t = *(const u32x2*)(pbase + (ptrdiff_t)(ok ? rI - 1 : 0) * NPROJ + st * 512); if (!ok) t = (u32x2){0u, 0u}; raw[rI][st] = t; } }
        f32x4 vprev, xprev;
#pragma unroll
        for (int i = 0; i < 8; ++i) {
            f32x4 uc[3];
#pragma unroll
            for (int st = 0; st < 3; ++st) {
                const f32x4 p0 = {bflo(raw[i][st].x), bfhi(raw[i][st].x), bflo(raw[i][st].y), bfhi(raw[i][st].y)};
                const f32x4 p1 = {bflo(raw[i + 1][st].x), bfhi(raw[i + 1][st].x), bflo(raw[i + 1][st].y), bfhi(raw[i + 1][st].y)};
                const f32x4 p2 = {bflo(raw[i + 2][st].x), bfhi(raw[i + 2][st].x), bflo(raw[i + 2][st].y), bfhi(raw[i + 2][st].y)};
                uc[st] = w[st][0] * p0 + w[st][1] * p1 + w[st][2] * p2 + bb[st]; }
            const f32x4 vv = uc[2] * uc[1];
            if (i & 1) { const int tp = (tb + i) >> 1;
#pragma unroll
                for (int e = 0; e < 4; ++e) { VL[(c + e) * 33 + tp] = pk2(vprev[e], vv[e]); XL[(c + e) * 33 + tp] = pk2(xprev[e], uc[0][e]); } }
            vprev = vv; xprev = uc[0];
        }
    }
    __syncthreads();
    const size_t obase = (size_t)512 * seqbase + s_tile;
    for (int it = tid; it < 2 * 512 * 8; it += 512) { const int arr = it >> 12, row = (it >> 3) & 511, ch = it & 7;
        const LAS unsigned* src = (arr ? XL : VL) + row * 33 + 4 * ch; u32x4 v; v.x = src[0]; v.y = src[1]; v.z = src[2]; v.w = src[3];
        *(u32x4*)((arr ? x0T : vT) + obase + (size_t)row * L + 8 * ch) = v; }
    __syncthreads();
}

template <int L, int B>
__device__ __forceinline__ void toeplitz_unit(const bf16_t* Rg, const bf16_t* vT, bf16_t* hyT, const bf16_t* x0T, const float* fbias, LAS unsigned char* lds, int c, size_t kind_base, int tid, int wave, int lane) {
    constexpr int NB = L / 64, T1PT = 32 / B, PAD = T1PT - 1, NTILES = NB / T1PT, NTW = NTILES / 8;
    constexpr int VROWS = (NB + 2 * PAD) * B, VBYTES = VROWS * 144;
    LAS unsigned char* Vl = lds;
    LAS unsigned* E = (LAS unsigned*)(lds + VBYTES);
    LAS unsigned* O = E + L + 16;
    const bf16_t* vch = vT + kind_base + (size_t)c * L;
    bf16_t* hch = hyT + kind_base + (size_t)c * L;
    const bf16_t* xch = x0T + kind_base + (size_t)c * L;
    for (int idx = tid; idx < NB * B * 8; idx += 512) { const int ch = idx & 7, row = idx >> 3, b = row % B, s1 = row / B;
        const u32x4 v = *(const u32x4*)(vch + (size_t)b * 512 * L + 64 * s1 + 8 * ch);
        *(LAS u32x4*)(Vl + ((s1 + PAD) * B + b) * 144 + 16 * ch) = v; }
    for (int idx = tid; idx < 2 * PAD * B * 9; idx += 512) { const int ch = idx % 9, row = idx / 9; const int rrow = row < PAD * B ? row : (NB * B + row);
        *(LAS u32x4*)(Vl + rrow * 144 + 16 * ch) = (u32x4){0u, 0u, 0u, 0u}; }
    { const u32x4* src = (const u32x4*)(Rg + (size_t)c * 2 * L);
      for (int idx = tid; idx < L / 4; idx += 512) { const u32x4 v = src[idx]; *(LAS u32x4*)(E + 4 * idx) = v; } }
    __syncthreads();
    for (int e = tid; e < L; e += 512) { const unsigned lo = E[e], hi = (e + 1 < L) ? E[e + 1] : 0u; O[e] = (lo >> 16) | (hi << 16); }
    __syncthreads();
    const int rr = lane & 31, hh = lane >> 5;
    const LAS unsigned* fb = ((rr & 1) ? O : E) + ((L + 8 * hh - rr - (rr & 1)) >> 1);
    f32x16 acc[NTW][2];
#pragma unroll
    for (int i = 0; i < NTW; ++i)
#pragma unroll
        for (int m = 0; m < 2; ++m)
#pragma unroll
            for (int k = 0; k < 16; ++k) acc[i][m][k] = 0.f;
    const int t1l = rr / B, bcol = rr % B;
    const int dlo = T1PT * wave - (NB - 1), dhi = T1PT * (wave + 8 * (NTW - 1)) + T1PT - 1;
    bf16x8 F[6];
#pragma unroll
    for (int q = 0; q < 6; ++q) { const LAS unsigned* p = fb - 8 * (4 * dlo - 3 + q); u32x4 w; w.x = p[0]; w.y = p[1]; w.z = p[2]; w.w = p[3]; F[q] = __builtin_bit_cast(bf16x8, w); }
    int vrow[NTW];
#pragma unroll
    for (int i = 0; i < NTW; ++i) vrow[i] = T1PT * (wave + 8 * i) + t1l + PAD;
    bf16x8 Bc[NTW][4];
#pragma unroll
    for (int i = 0; i < NTW; ++i) { const LAS unsigned char* vb = Vl + (max(vrow[i] - dlo, 0) * B + bcol) * 144 + 16 * hh;
#pragma unroll
        for (int kt = 0; kt < 4; ++kt) Bc[i][kt] = *(const LAS bf16x8*)(vb + 32 * kt); }
    for (int d = dlo; d <= dhi; ++d) {
        bf16x8 Fn[4], Bn[NTW][4];
#pragma unroll
        for (int q = 0; q < 4; ++q) { const LAS unsigned* p = fb - 8 * (4 * d + 3 + q); u32x4 w; w.x = p[0]; w.y = p[1]; w.z = p[2]; w.w = p[3]; Fn[q] = __builtin_bit_cast(bf16x8, w); }
#pragma unroll
        for (int i = 0; i < NTW; ++i) { const LAS unsigned char* vb = Vl + (max(vrow[i] - d - 1, 0) * B + bcol) * 144 + 16 * hh;
#pragma unroll
            for (int kt = 0; kt < 4; ++kt) Bn[i][kt] = *(const LAS bf16x8*)(vb + 32 * kt); }
#pragma unroll
        for (int i = 0; i < NTW; ++i) { const int j = wave + 8 * i;
            if (d >= T1PT * j - (NB - 1) && d <= T1PT * j + T1PT - 1) {
#pragma unroll
                for (int kt = 0; kt < 4; ++kt)
#pragma unroll
                    for (int mt = 0; mt < 2; ++mt) acc[i][mt] = MFMA32(F[2 * mt - kt + 3], Bc[i][kt], acc[i][mt]);
            } }
        F[0] = F[4]; F[1] = F[5]; F[2] = Fn[0]; F[3] = Fn[1]; F[4] = Fn[2]; F[5] = Fn[3];
#pragma unroll
        for (int i = 0; i < NTW; ++i)
#pragma unroll
            for (int kt = 0; kt < 4; ++kt) Bc[i][kt] = Bn[i][kt];
    }
    const float fbv = fbias[c];
#pragma unroll
    for (int i = 0; i < NTW; ++i) { const int j = wave + 8 * i, t1 = T1PT * j + t1l;
#pragma unroll
        for (int mt = 0; mt < 2; ++mt)
#pragma unroll
            for (int g = 0; g < 4; ++g) { const int t0 = 32 * mt + 8 * g + 4 * hh;
                const u32x2 vv = *(const LAS u32x2*)(Vl + ((t1 + PAD) * B + bcol) * 144 + 2 * t0);
                const size_t go = (size_t)bcol * 512 * L + 64 * t1 + t0;
                const u32x2 xv = *(const u32x2*)(xch + go);
                const float y0 = (acc[i][mt][4 * g + 0] + fbv * bflo(vv.x)) * bflo(xv.x), y1 = (acc[i][mt][4 * g + 1] + fbv * bfhi(vv.x)) * bfhi(xv.x);
                const float y2 = (acc[i][mt][4 * g + 2] + fbv * bflo(vv.y)) * bflo(xv.y), y3 = (acc[i][mt][4 * g + 3] + fbv * bfhi(vv.y)) * bfhi(xv.y);
                u32x2 w; w.x = pk2(y0, y1); w.y = pk2(y2, y3);
                *(u32x2*)(hch + go) = w; } }
    __syncthreads();
}

__device__ __forceinline__ void hynorm_unit(const bf16_t* hyT, const float* g_hy, bf16_t* merged, LAS unsigned char* lds, int u, int tid, int wave, int lane) {
    const int tok0 = 64 * u; int L, s_tile, seqbase;
    if (u < 512) { L = 2048; s_tile = (u & 31) * 64; seqbase = (u >> 5) * 2048; } else { const int v = u - 512; L = 4096; s_tile = (v & 63) * 64; seqbase = TOK_P + (v >> 6) * 4096; }
    LAS unsigned char* HL = lds;
    LAS float* ssq = (LAS float*)(lds + 512 * 144);
    const size_t ibase = (size_t)512 * seqbase + s_tile;
    for (int it = tid; it < 512 * 8; it += 512) { const int row = it >> 3, ch = it & 7;
        *(LAS u32x4*)(HL + row * 144 + 16 * ch) = *(const u32x4*)(hyT + ibase + (size_t)row * L + 8 * ch); }
    __syncthreads();
    float ss = 0.f;
    const LAS unsigned short* col = (const LAS unsigned short*)(HL + (64 * wave) * 144) + lane;
#pragma unroll 8
    for (int k = 0; k < 64; ++k) { const float v = bf2f(col[k * 72]); ss += v * v; }
    ssq[wave * 64 + lane] = ss;
    __syncthreads();
    float tot = 0.f;
#pragma unroll
    for (int w = 0; w < 8; ++w) tot += ssq[w * 64 + lane];
    const float rs = 1.0f / sqrtf(tot * (1.0f / 512.0f) + RMS_EPS_F);
    bf16_t* orow = merged + (size_t)(tok0 + lane) * DM + 512 + 64 * wave;
#pragma unroll
    for (int k8 = 0; k8 < 8; ++k8) { float v[8];
#pragma unroll
        for (int e = 0; e < 8; ++e) v[e] = bf2f(col[(8 * k8 + e) * 72]) * rs * g_hy[64 * wave + 8 * k8 + e];
        u32x4 w; w.x = pk2(v[0], v[1]); w.y = pk2(v[2], v[3]); w.z = pk2(v[4], v[5]); w.w = pk2(v[6], v[7]);
        *(u32x4*)(orow + 8 * k8) = w; }
    __syncthreads();
}

__device__ __forceinline__ void ln_rows(float* io, bf16_t* ob, const float* g, const float* b, int gw, int NGW, int lane) {
    f32x4 gv[4], bv[4];
#pragma unroll
    for (int j = 0; j < 4; ++j) { gv[j] = ((const f32x4*)g)[lane + 64 * j]; bv[j] = ((const f32x4*)b)[lane + 64 * j]; }
    for (int m = gw; m < T_TOK; m += NGW) {
        f32x4* xr = (f32x4*)(io + (size_t)m * DM) + lane;
        f32x4 v[4]; float s = 0.f;
#pragma unroll
        for (int j = 0; j < 4; ++j) { v[j] = xr[64 * j]; s += (v[j].x + v[j].y) + (v[j].z + v[j].w); }
        const float mean = wave_sum(s) * (1.f / DM); float s2 = 0.f;
#pragma unroll
        for (int j = 0; j < 4; ++j) { v[j] = v[j] - mean; s2 += (v[j].x * v[j].x + v[j].y * v[j].y) + (v[j].z * v[j].z + v[j].w * v[j].w); }
        const float rstd = 1.f / sqrtf(wave_sum(s2) * (1.f / DM) + LN_EPS_F);
#pragma unroll
        for (int j = 0; j < 4; ++j) { const f32x4 y = v[j] * rstd * gv[j] + bv[j]; xr[64 * j] = y;
            if (ob) { u32x2 w; w.x = pk2(y.x, y.y); w.y = pk2(y.z, y.w); ((u32x2*)(ob + (size_t)m * DM))[lane + 64 * j] = w; } }
    }
}

struct V8 { f32x4 a, b; };
__device__ __forceinline__ V8 unpack8(u32x4 r) { V8 o; o.a = (f32x4){bflo(r.x), bfhi(r.x), bflo(r.y), bfhi(r.y)}; o.b = (f32x4){bflo(r.z), bfhi(r.z), bflo(r.w), bfhi(r.w)}; return o; }
__device__ __forceinline__ void convgelu_chunk(const bf16_t* U, bf16_t* H, const float* cw, const float* cb, int L, int gtid, int nthreads) {
    constexpr int NG = DFF / 8, RUN = 16;
    const int nitems = (CHUNK / RUN) * NG;
    for (int it = gtid; it < nitems; it += nthreads) {
        const int g = it % NG, run = it / NG, c = 8 * g, t0 = run * RUN, s0 = t0 % L;
        V8 wa[3], wg[3], ba, bg;
#pragma unroll
        for (int k = 0; k < 3; ++k) { wa[k].a = *(const f32x4*)(cw + k * NFF + c); wa[k].b = *(const f32x4*)(cw + k * NFF + c + 4); wg[k].a = *(const f32x4*)(cw + k * NFF + DFF + c); wg[k].b = *(const f32x4*)(cw + k * NFF + DFF + c + 4); }
        ba.a = *(const f32x4*)(cb + c); ba.b = *(const f32x4*)(cb + c + 4); bg.a = *(const f32x4*)(cb + DFF + c); bg.b = *(const f32x4*)(cb + DFF + c + 4);
        const bf16_t* ua = U + (size_t)t0 * NFF + c; const bf16_t* ug = ua + DFF;
        const u32x4 z4 = {0u, 0u, 0u, 0u};
        V8 pa, pg, ca, cg_;
        { const bool okp = s0 > 0; const ptrdiff_t rp = okp ? -(ptrdiff_t)NFF : 0; u32x4 a = *(const u32x4*)(ua + rp), b = *(const u32x4*)(ug + rp); if (!okp) { a = z4; b = z4; }
          pa = unpack8(a); pg = unpack8(b); ca = unpack8(*(const u32x4*)(ua)); cg_ = unpack8(*(const u32x4*)(ug)); }
#pragma unroll 4
        for (int i = 0; i < RUN; ++i) {
            const bool okn = s0 + i + 1 < L; const size_t rn = (size_t)(okn ? i + 1 : i) * NFF; u32x4 a = *(const u32x4*)(ua + rn), b = *(const u32x4*)(ug + rn); if (!okn) { a = z4; b = z4; }
            const V8 na = unpack8(a), ng = unpack8(b);
            const f32x4 va0 = wa[0].a * pa.a + wa[1].a * ca.a + wa[2].a * na.a + ba.a, va1 = wa[0].b * pa.b + wa[1].b * ca.b + wa[2].b * na.b + ba.b;
            const f32x4 vg0 = wg[0].a * pg.a + wg[1].a * cg_.a + wg[2].a * ng.a + bg.a, vg1 = wg[0].b * pg.b + wg[1].b * cg_.b + wg[2].b * ng.b + bg.b;
            const pg8::f32x2 g0 = pg8::gelu_pk((pg8::f32x2){vg0[0], vg0[1]}), g1 = pg8::gelu_pk((pg8::f32x2){vg0[2], vg0[3]}), g2 = pg8::gelu_pk((pg8::f32x2){vg1[0], vg1[1]}), g3 = pg8::gelu_pk((pg8::f32x2){vg1[2], vg1[3]});
            u32x4 w; w.x = pk2(va0[0] * g0.x, va0[1] * g0.y); w.y = pk2(va0[2] * g1.x, va0[3] * g1.y); w.z = pk2(va1[0] * g2.x, va1[1] * g2.y); w.w = pk2(va1[2] * g3.x, va1[3] * g3.y);
            *(u32x4*)(H + (size_t)(t0 + i) * DFF + c) = w;
            pa = ca; pg = cg_; ca = na; cg_ = ng;
        }
    }
}

constexpr int NPHASE = 15;
__global__ void __launch_bounds__(512) fwd_kernel(Args A) {
    extern __shared__ __attribute__((aligned(16))) unsigned char lds_raw[];
    LAS unsigned char* lds = (LAS unsigned char*)lds_raw;
    cg::grid_group grid = cg::this_grid();
    const int tid = threadIdx.x, lane = tid & 63, wave = __builtin_amdgcn_readfirstlane(tid >> 6);
    const int bx = blockIdx.x, G = gridDim.x;
    unsigned char* ws = A.ws;
    bf16_t* xb = (bf16_t*)(ws + WS_XB); bf16_t* merged = xb;
    bf16_t* proj = (bf16_t*)(ws + WS_PROJ);
    bf16_t* vT = (bf16_t*)A.out; bf16_t* x0T = vT + (size_t)T_TOK * HYW; bf16_t* hyT = x0T + (size_t)T_TOK * HYW;
    bf16_t* x1b = (bf16_t*)(ws + WS_X1B); bf16_t* ubuf = (bf16_t*)(ws + WS_U); bf16_t* hbuf = (bf16_t*)(ws + WS_HID);
    const int lo = A.ph_lo, hi = A.ph_hi;
    volatile LAS unsigned* bst = (volatile LAS unsigned*)(lds + LDS_BYTES - 64);
    if (tid < 16) bst[tid] = 0u;
    __syncthreads();
    XcdBarrier xbar = xcd_barrier_post((unsigned*)ws + A.li * XCD_BAR_WORDS, bst);
#ifndef PHASE_MASK
#define PHASE_MASK 0x7fff
#endif
#define IN(k) (((PHASE_MASK >> (k)) & 1) && lo <= (k) && (k) < hi)
#ifndef DUP_PHASE
#define DUP_PHASE -1
#endif
#define REPS(k)
#ifndef CG_SEAMS
#define CG_SEAMS 1
#endif
#define SEAM(k) do { if (IN(k) && IN((k) + 1)) { if ((k) < CG_SEAMS) grid.sync(); else xcd_barrier(xbar); } } while (0)
#ifdef EXTRA_SYNCS
    for (int i_ = 0; i_ < EXTRA_SYNCS; ++i_) grid.sync();
#endif
    if (IN(0)) REPS(0) { p0_prologue(A, lds, tid, wave, lane); }
    SEAM(0);
    if (IN(1)) REPS(1) { pg8::Gemm g{xb, (const bf16_t*)(ws + WS_WIN), T_TOK, NPROJ, DM}; pg8::StaticOrder S; S.init(T_TOK, NPROJ, G, bx);
        pg8::EpiBf16<0> E{proj, NPROJ, nullptr, 0, 0, 1.f};
        pg8::gemm_phase<pg8::EpiBf16<0>, pg8::StaticOrder, true, true>(lds, g, S, E); }
    SEAM(1);
    if (IN(2)) {
#ifndef ATT_REPS
#define ATT_REPS 1
#endif
        for (int rep_ = 0; rep_ < ATT_REPS; ++rep_) { if (G == 256) { for (int i = 0; i < 3; ++i) attn_unit(proj, A.in[I_RPB], A.in[I_GA], merged, lds, 96 * (bx & 7) + (bx >> 3) + 32 * i, wave, lane); }
            else { for (int u = bx; u < 768; u += G) attn_unit(proj, A.in[I_RPB], A.in[I_GA], merged, lds, u, wave, lane); } }
        REPS(20) for (int u = bx; u < 768; u += G) hyprep_unit(proj, A.in[I_SW], A.in[I_SB], vT, x0T, lds, u, tid);
    }
    SEAM(2);
    if (IN(3)) {
        for (int rep_ = 0; rep_ < T_REPS; ++rep_) for (int u = bx; u < 1024; u += G) {
            if (u < 512) toeplitz_unit<L_P, 16>((const bf16_t*)(ws + WS_FILT_P), vT, hyT, x0T, A.in[I_FBIAS], lds, u, 0, tid, wave, lane);
            else toeplitz_unit<L_S, 4>((const bf16_t*)(ws + WS_FILT_S), vT, hyT, x0T, A.in[I_FBIAS], lds, u - 512, (size_t)512 * TOK_P, tid, wave, lane);
        }
    }
    SEAM(3);
    if (IN(4)) REPS(4) { for (int u = bx; u < 768; u += G) hynorm_unit(hyT, A.in[I_GH], merged, lds, u, tid, wave, lane); }
    SEAM(4);
    if (IN(5)) REPS(5) {
        { pg8::Gemm g{merged, (const bf16_t*)(ws + WS_WOUT), TOK_P, DM, DM}; pg8::StaticOrder S; S.init(TOK_P, DM, G, bx);
          pg8::EpiAxpyF32 E{A.in[I_XP], A.out, DM, ALPHA_F};
          pg8::gemm_phase<pg8::EpiAxpyF32, pg8::StaticOrder, true, true>(lds, g, S, E); }
        { pg8::Gemm g{merged + (size_t)TOK_P * DM, (const bf16_t*)(ws + WS_WOUT), T_TOK - TOK_P, DM, DM}; pg8::StaticOrder S; S.init(T_TOK - TOK_P, DM, G, bx);
          pg8::EpiAxpyF32 E{A.in[I_XS], A.out + (size_t)TOK_P * DM, DM, ALPHA_F};
          pg8::gemm_phase<pg8::EpiAxpyF32, pg8::StaticOrder, true, true>(lds, g, S, E); }
    }
    SEAM(5);
    if (IN(6)) ln_rows(A.out, x1b, A.in[I_LN1G], A.in[I_LN1B], bx * 8 + wave, G * 8, lane);
    SEAM(6);
#pragma unroll
    for (int k = 0; k < NCHUNK + 1; ++k) {
        const int ph = 7 + 2 * k;
        if (IN(ph)) {
            if (k >= 1) { pg8::Gemm g{hbuf, (const bf16_t*)(ws + WS_WF2), CHUNK, DM, DFF}; pg8::StaticOrder S; S.init(CHUNK, DM, G, bx);
                float* o = A.out + (size_t)(k - 1) * CHUNK * DM; pg8::EpiAxpyF32 E{o, o, DM, ALPHA_F};
                pg8::gemm_phase<pg8::EpiAxpyF32, pg8::StaticOrder, true, true>(lds, g, S, E); }
            if (k < NCHUNK) REPS(7 + 100 * k) { pg8::Gemm g{x1b + (size_t)k * CHUNK * DM, (const bf16_t*)(ws + WS_WF1), CHUNK, NFF, DM}; pg8::StaticOrder S; S.init(CHUNK, NFF, G, bx);
                pg8::EpiBf16<0> E{ubuf, NFF, nullptr, 0, 0, 1.f};
                pg8::gemm_phase<pg8::EpiBf16<0>, pg8::StaticOrder, true, true>(lds, g, S, E); }
        }
        SEAM(ph);
        if (k < NCHUNK) {
            if (IN(ph + 1)) for (int rep_ = 0; rep_ < (k == 0 ? CG_REPS : 1); ++rep_) convgelu_chunk(ubuf, hbuf, A.in[I_FFCW], A.in[I_FFCB], k < 2 ? L_P : L_S, bx * 512 + tid, G * 512);
            SEAM(ph + 1);
        }
    }
    if (IN(14)) ln_rows(A.out, nullptr, A.in[I_LN2G], A.in[I_LN2B], bx * 8 + wave, G * 8, lane);
#undef IN
#undef SEAM
}

#ifndef MK_PER_PHASE
#define MK_PER_PHASE 0
#endif
extern "C" void kernel_launch(void* const* d_in, const int* in_sizes, int n_in, void* d_out, int out_size, void* d_ws, size_t ws_size, hipStream_t stream) {
    static int grid = 0;
    if (grid == 0) {
        if (n_in != 24 || out_size != T_TOK * DM || ws_size < WS_NEED) { fprintf(stderr, "kernel_launch: unexpected shapes n_in %d out %d ws %zu\n", n_in, out_size, ws_size); grid = -1; return; }
        int dev = 0, cus = 0, per_cu = 0;
        hipGetDevice(&dev); hipDeviceGetAttribute(&cus, hipDeviceAttributeMultiprocessorCount, dev);
        if (hipFuncSetAttribute((const void*)fwd_kernel, hipFuncAttributeMaxDynamicSharedMemorySize, LDS_BYTES) != hipSuccess) { fprintf(stderr, "hipFuncSetAttribute failed\n"); grid = -1; return; }
        if (hipOccupancyMaxActiveBlocksPerMultiprocessor(&per_cu, (const void*)fwd_kernel, 512, LDS_BYTES) != hipSuccess || per_cu < 1) { fprintf(stderr, "occupancy query: %d\n", per_cu); per_cu = 1; }
        (void)hipGetLastError();
        grid = cus * 1;
        fprintf(stderr, "kernel_launch: grid %d (cus %d, per_cu %d) ws %zu\n", grid, cus, per_cu, ws_size);
    }
    if (grid < 0) return;
    Args a{};
    for (int i = 0; i < 24; ++i) a.in[i] = (const float*)d_in[i];
    a.out = (float*)d_out; a.ws = (unsigned char*)d_ws;
#if MK_PER_PHASE
    for (int p = 0; p < NPHASE; ++p) { a.ph_lo = p; a.ph_hi = p + 1; hipLaunchKernelGGL(fwd_kernel, dim3(grid), dim3(512), LDS_BYTES, stream, a); }
#else
    void* args[] = {&a};
    (void)hipMemsetAsync(d_ws, 0, 65536, stream);
#if DUP_PHASE >= 0
    a.ph_lo = 0; a.ph_hi = DUP_PHASE + 1; a.li = 1;
    (void)hipLaunchCooperativeKernel((const void*)fwd_kernel, dim3(grid), dim3(512), args, LDS_BYTES, stream);
    a.ph_lo = DUP_PHASE; a.ph_hi = NPHASE; a.li = 0;
#else
    a.ph_lo = 0; a.ph_hi = NPHASE;
#endif
    hipError_t e = hipLaunchCooperativeKernel((const void*)fwd_kernel, dim3(grid), dim3(512), args, LDS_BYTES, stream);
    if (e != hipSuccess) fprintf(stderr, "cooperative launch failed: %s (grid %d)\n", hipGetErrorString(e), grid);
#endif
}
```
